# Optimizing an MI355X kernel written in HIP

```python
import jax, jax.numpy as jnp
from jax import lax
import numpy as np

D_MODEL = 2048
BATCH = 8
SEQ = 4096
DEPTH = 2
DEC_BATCH = 16
DEC_SEQ = 64
PAST_LEN = 4096

CHUNK = 64
N_HEADS = 8
HEAD_DIM = 128
N_KV_HEADS = 2
GROUP = N_HEADS // N_KV_HEADS
ATTN_W = N_HEADS * HEAD_DIM
KV_W = N_KV_HEADS * HEAD_DIM
N_IDX_HEADS = 16
IDX_DIM = 64
IDX_Q_W = N_IDX_HEADS * IDX_DIM
MAX_TOPK = 256
Q_BLOCK = 128
CONV_W = 512
CONV_K = 3
POOL_W = 512
POOL_WINDOWS = (2, 4, 8, 16)
N_POOL_GROUPS = 4
POOL_GROUP = POOL_W // N_POOL_GROUPS
POOL_HIST = 15
ROPE_THETA = 10000.0
EPS = 1e-6

SPLIT_SIZES = (ATTN_W, KV_W, KV_W, IDX_Q_W, IDX_DIM, N_IDX_HEADS, ATTN_W,
               CONV_W, CONV_W, CONV_W, CONV_W,
               POOL_W, POOL_W,
               D_MODEL, D_MODEL, D_MODEL)
IN_W = 2 * ATTN_W + 2 * KV_W + IDX_Q_W + IDX_DIM + N_IDX_HEADS + 4 * CONV_W + 2 * POOL_W + 3 * D_MODEL

kernel_name = "hybrid_dsa_conv_pool_stream_step"


def split_cols(p):
    offs = np.cumsum(np.array(SPLIT_SIZES))[:-1].tolist()
    return jnp.split(p, offs, axis=-1)


def rms_norm(x, g):
    xf = x.astype(jnp.float32)
    y = xf * lax.rsqrt(jnp.mean(xf * xf, axis=-1, keepdims=True) + EPS)
    return (y * g.astype(jnp.float32)).astype(x.dtype)


def rope(x, pos):
    half = x.shape[-1] // 2
    inv = ROPE_THETA ** (-jnp.arange(half, dtype=jnp.float32) / half)
    ang = pos.astype(jnp.float32)[:, None] * inv[None, :]
    cos = jnp.cos(ang)[None, :, None, :]
    sin = jnp.sin(ang)[None, :, None, :]
    x1 = x[..., :half].astype(jnp.float32)
    x2 = x[..., half:].astype(jnp.float32)
    return jnp.concatenate([x1 * cos - x2 * sin, x2 * cos + x1 * sin], axis=-1).astype(x.dtype)


def sparse_attend(q, iq, iw, q_pos, k_all, v_all, ik_all, topk):
    B, Tq = q.shape[:2]
    L = k_all.shape[1]
    dots = jnp.einsum('bthd,bsd->bths', iq.astype(jnp.float32), ik_all.astype(jnp.float32))
    score = jnp.einsum('bths,bth->bts', jax.nn.relu(dots), iw.astype(jnp.float32))
    q_chunk = q_pos // CHUNK
    admissible = (jnp.arange(L) // CHUNK)[None, :] <= q_chunk[:, None]
    score = jnp.where(admissible[None], score, -jnp.inf)
    _, idx = lax.top_k(score, topk)
    valid = (idx // CHUNK) <= q_chunk[None, :, None]
    k_sel = jax.vmap(lambda kb, ib: kb[ib])(k_all, idx)
    v_sel = jax.vmap(lambda vb, ib: vb[ib])(v_all, idx)
    qg = q.reshape(B, Tq, N_KV_HEADS, GROUP, HEAD_DIM).astype(jnp.float32)
    logits = jnp.einsum('btkgd,btnkd->btkgn', qg, k_sel.astype(jnp.float32)) * (HEAD_DIM ** -0.5)
    logits = jnp.where(valid[:, :, None, None, :], logits, -jnp.inf)
    p = jax.nn.softmax(logits, axis=-1)
    o = jnp.einsum('btkgn,btnkd->btkgd', p, v_sel.astype(jnp.float32))
    return o.reshape(B, Tq, ATTN_W).astype(q.dtype)


def prompt_attention(q, iq, iw, pos, k, v, ik, topk):
    B, T = q.shape[:2]
    nb = T // Q_BLOCK

    def blocks(a):
        return jnp.moveaxis(a.reshape((B, nb, Q_BLOCK) + a.shape[2:]), 1, 0)

    def one(args):
        qb, iqb, iwb, pb = args
        return sparse_attend(qb, iqb, iwb, pb, k, v, ik, topk)

    o = lax.map(one, (blocks(q), blocks(iq), blocks(iw), pos.reshape(nb, Q_BLOCK)))
    return jnp.moveaxis(o, 0, 1).reshape(B, T, ATTN_W)


def mixer_layer(x, pos, past, norm_g, w_in, conv_w, conv_b, pool_w, pool_scale,
                lift_a, lift_b, lift_c, w_out, topk):
    B, T, _ = x.shape
    h = rms_norm(x, norm_g)
    (q, k, v, iq, ik, iw, gate_a, u, b_gate, c_gate, gate_b, p_in, gate_c,
     m_a, m_b, m_c) = split_cols(h @ w_in)
    q = rope(q.reshape(B, T, N_HEADS, HEAD_DIM), pos)
    k = rope(k.reshape(B, T, N_KV_HEADS, HEAD_DIM), pos)
    v = v.reshape(B, T, N_KV_HEADS, HEAD_DIM)
    iq = rope(iq.reshape(B, T, N_IDX_HEADS, IDX_DIM), pos)
    ik = rope(ik.reshape(B, T, 1, IDX_DIM), pos)[:, :, 0]
    iw = iw * ((IDX_DIM ** -0.5) * (N_IDX_HEADS ** -0.5))
    if past is None:
        conv_hist = jnp.zeros((B, CONV_K - 1, CONV_W), x.dtype)
        pool_hist = jnp.zeros((B, POOL_HIST, POOL_W), x.dtype)
        attn = prompt_attention(q, iq, iw, pos, k, v, ik, topk)
    else:
        ck, cv, cik, conv_hist, pool_hist = past
        k_all = jnp.concatenate([ck.astype(k.dtype), k], axis=1)
        v_all = jnp.concatenate([cv.astype(v.dtype), v], axis=1)
        ik_all = jnp.concatenate([cik.astype(ik.dtype), ik], axis=1)
        attn = sparse_attend(q, iq, iw, pos, k_all, v_all, ik_all, topk)
    y_a = attn * jax.nn.silu(gate_a)
    cin = c_gate * u
    xc = jnp.concatenate([conv_hist.astype(cin.dtype), cin], axis=1)
    conv = (xc[:, 0:T] * conv_w[0] + xc[:, 1:T + 1] * conv_w[1]
            + xc[:, 2:T + 2] * conv_w[2] + conv_b)
    y_b = b_gate * conv * jax.nn.silu(gate_b)
    xp = jnp.concatenate([pool_hist.astype(p_in.dtype), p_in], axis=1)
    cs = jnp.concatenate([jnp.zeros((B, 1, POOL_W), jnp.float32),
                          jnp.cumsum(xp.astype(jnp.float32), axis=1)], axis=1)
    end = cs[:, POOL_HIST + 1:]
    means = []
    for g, w in enumerate(POOL_WINDOWS):
        sl = slice(g * POOL_GROUP, (g + 1) * POOL_GROUP)
        start = cs[:, POOL_HIST + 1 - w:POOL_HIST + 1 - w + T, sl]
        cnt = jnp.minimum(w, pos + 1).astype(jnp.float32)[None, :, None]
        means.append((end[..., sl] - start) / cnt)
    pooled = jnp.concatenate(means, axis=-1)
    d = (pooled - p_in.astype(jnp.float32)).reshape(B, T, N_POOL_GROUPS, POOL_GROUP)
    mixed = jnp.einsum('btgc,gcd->btgd', d, pool_w.astype(jnp.float32)).reshape(B, T, POOL_W)
    y_c = (mixed * pool_scale.astype(jnp.float32)).astype(x.dtype) * jax.nn.silu(gate_c)
    z = (jax.nn.sigmoid(m_a) * (y_a @ lift_a) + jax.nn.sigmoid(m_b) * (y_b @ lift_b)
         + jax.nn.sigmoid(m_c) * (y_c @ lift_c))
    out = x + z @ w_out
    new_state = (k, v, ik, xc[:, -(CONV_K - 1):], xp[:, -POOL_HIST:])
    return out, new_state


def setup_inputs(seed: int = 0) -> dict:
    key = jax.random.key(seed)
    ks = jax.random.split(key, 20)
    f = jnp.float32
    nrm = lambda k, s, sc: jax.random.normal(k, s, f) * sc
    return {
        "x_prompt": nrm(ks[0], (BATCH, SEQ, D_MODEL), 1.0),
        "x_sample": nrm(ks[1], (DEC_BATCH, DEC_SEQ, D_MODEL), 1.0),
        "cache_k": nrm(ks[2], (DEPTH, DEC_BATCH, PAST_LEN, N_KV_HEADS, HEAD_DIM), 1.0),
        "cache_v": nrm(ks[3], (DEPTH, DEC_BATCH, PAST_LEN, N_KV_HEADS, HEAD_DIM), 1.0),
        "cache_idx_k": nrm(ks[4], (DEPTH, DEC_BATCH, PAST_LEN, IDX_DIM), 1.0),
        "state_conv": nrm(ks[5], (DEPTH, DEC_BATCH, CONV_K - 1, CONV_W), 1.0),
        "state_pool": nrm(ks[6], (DEPTH, DEC_BATCH, POOL_HIST, POOL_W), 1.0),
        "norm_g": 1.0 + nrm(ks[7], (DEPTH, D_MODEL), 0.01),
        "w_in": nrm(ks[8], (DEPTH, D_MODEL, IN_W), D_MODEL ** -0.5),
        "conv_w": nrm(ks[9], (DEPTH, CONV_K, CONV_W), CONV_K ** -0.5),
        "conv_b": nrm(ks[10], (DEPTH, CONV_W), 0.01),
        "pool_w": nrm(ks[11], (DEPTH, N_POOL_GROUPS, POOL_GROUP, POOL_GROUP), POOL_GROUP ** -0.5),
        "pool_scale": 1.0 + nrm(ks[12], (DEPTH, POOL_W), 0.1),
        "lift_a": nrm(ks[13], (DEPTH, ATTN_W, D_MODEL), ATTN_W ** -0.5),
        "lift_b": nrm(ks[14], (DEPTH, CONV_W, D_MODEL), CONV_W ** -0.5),
        "lift_c": nrm(ks[15], (DEPTH, POOL_W, D_MODEL), POOL_W ** -0.5),
        "w_out": nrm(ks[16], (DEPTH, D_MODEL, D_MODEL), D_MODEL ** -0.5),
        "final_norm_g": 1.0 + nrm(ks[17], (D_MODEL,), 0.01),
    }


def reference(x_prompt, x_sample, cache_k, cache_v, cache_idx_k, state_conv, state_pool,
              norm_g, w_in, conv_w, conv_b, pool_w, pool_scale, lift_a, lift_b, lift_c,
              w_out, final_norm_g):
    seq = x_prompt.shape[1]
    past_len = cache_k.shape[2]
    dec_seq = x_sample.shape[1]
    topk_prompt = min(MAX_TOPK, seq // 4)
    topk_sample = min(MAX_TOPK, (past_len + dec_seq) // 4)
    pos_prompt = jnp.arange(seq, dtype=jnp.int32)
    pos_sample = past_len + jnp.arange(dec_seq, dtype=jnp.int32)

    hp, hs = x_prompt, x_sample
    p_states = ([], [], [], [], [])
    s_states = ([], [], [], [], [])
    for l in range(DEPTH):
        params = (norm_g[l], w_in[l], conv_w[l], conv_b[l], pool_w[l], pool_scale[l],
                  lift_a[l], lift_b[l], lift_c[l], w_out[l])
        hp, st_p = mixer_layer(hp, pos_prompt, None, *params, topk_prompt)
        past = (cache_k[l], cache_v[l], cache_idx_k[l], state_conv[l], state_pool[l])
        hs, st_s = mixer_layer(hs, pos_sample, past, *params, topk_sample)
        for i in range(5):
            p_states[i].append(st_p[i])
            s_states[i].append(st_s[i])
    y_prompt = rms_norm(hp, final_norm_g)
    y_sample = rms_norm(hs, final_norm_g)
    k_prompt = jnp.stack(p_states[0])
    v_prompt = jnp.stack(p_states[1])
    idxk_prompt = jnp.stack(p_states[2])
    conv_prompt = jnp.stack(p_states[3])
    pool_prompt = jnp.stack(p_states[4])
    k_sample = jnp.stack(s_states[0])
    v_sample = jnp.stack(s_states[1])
    idxk_sample = jnp.stack(s_states[2])
    conv_sample = jnp.stack(s_states[3])
    pool_sample = jnp.stack(s_states[4])
    return (y_prompt, y_sample, k_prompt, v_prompt, idxk_prompt, conv_prompt, pool_prompt,
            k_sample, v_sample, idxk_sample, conv_sample, pool_sample)
```

```cpp
#include <hip/hip_runtime.h>
#include <cstdio>
#include <cstdint>

namespace pg8 {
#define PG8_LAS __attribute__((address_space(3)))
typedef unsigned short bf16_t;
typedef short bf16x8 __attribute__((ext_vector_type(8)));
typedef float f32x4 __attribute__((ext_vector_type(4)));
typedef unsigned u32x4 __attribute__((ext_vector_type(4)));
constexpr int BM = 256, BK = 64, HALF = 128, HTB = HALF * BK * 2  , STAGE_BYTES = 8 * HTB, NXCD = 8, WGM = 8;

__host__ __device__ __forceinline__ int lds_byte(int r, int c) { const int st = (r >> 4) * 2 + (c >> 5), rr = r & 15, cc = c & 31, ob = rr * 64 + cc * 2; return st * 1024 + (ob ^ (((ob >> 9) & 1) << 5)); }
__host__ __device__ __forceinline__ void stage_rc(int b, int& R, int& C) { const int st = b / 1024, sb = b % 1024, swz = sb ^ (((sb >> 9) & 1) << 5); R = (st >> 1) * 16 + swz / 64; C = (st & 1) * 32 + (swz % 64) / 2; }
__host__ __device__ __forceinline__ int perm32(int rho) { const int n = rho >> 4, i = rho & 15; return 8 * (i >> 2) + 4 * n + (i & 3); }

struct Unit { int pm, pn, koff, seg; };
struct Gemm { const bf16_t* A; const bf16_t* Bt; int M, N, K, lda, ldb; };

struct StaticOrder {
    int nM, nN, nwg, G, c;
    __host__ __device__ void init(int M, int N, int G_, int c_) { nM = M / BM; nN = N / BM; nwg = nM * nN; G = G_; c = c_; }
    __host__ __device__ bool next(int i, Unit& u) const {
        const long L = (long)i * G + c; if (L >= nwg) return false;
        int wgid = (int)L; { const int q = nwg / NXCD, r = nwg % NXCD, xcd = wgid % NXCD, off = wgid / NXCD; wgid = (xcd < r ? xcd * (q + 1) : r * (q + 1) + (xcd - r) * q) + off; }
        const int nig = WGM * nN, gid = wgid / nig, fm = gid * WGM, gsz = (nM - fm) < WGM ? (nM - fm) : WGM;
        u.pm = fm + ((wgid % nig) % gsz); u.pn = (wgid % nig) / gsz; u.koff = 0; u.seg = 0; return true;
    }
    __device__ __forceinline__ void a_ready(const Unit&) const {}
    __device__ __forceinline__ void done(const Unit&) const {}
};
template <int NSEG, int KS> struct SegOrder : StaticOrder {
    __host__ __device__ bool next(int i, Unit& u) const { if (!StaticOrder::next(i / NSEG, u)) return false; u.seg = i % NSEG; u.koff = u.seg * KS; return true; }
};
__device__ __forceinline__ unsigned cvt_pk_bf16(float lo, float hi) { typedef float f2_ __attribute__((ext_vector_type(2))); typedef __bf16 b2_ __attribute__((ext_vector_type(2))); const b2_ r = __builtin_convertvector((f2_){lo, hi}, b2_); return __builtin_bit_cast(unsigned, r); }

template <class Epi, class Sched, bool ALIGN_EPI = false, bool SP2 = false>
__device__ __forceinline__ void gemm_phase(PG8_LAS unsigned char* lds, const Gemm g, const Sched& S, const Epi& E) {
    int tid_ = threadIdx.x; asm volatile("" : "+v"(tid_));
    const int tid = tid_, wid = __builtin_amdgcn_readfirstlane(tid >> 6), lane = tid & 63, wr = wid >> 2, wc = wid & 3, fr = lane & 15, fq = lane >> 4;
    const int K = g.K, nt = K / BK;
    unsigned voffA[2], voffB[2];
#pragma unroll
    for (int i = 0; i < 2; ++i) { int R, C; stage_rc(tid * 16 + i * 8192, R, C); const int Rb = Epi::PERM ? ((R & ~31) + perm32(R & 31)) : R;
        voffA[i] = (unsigned)(R * g.lda + C) * 2u; voffB[i] = (unsigned)(Rb * g.ldb + C) * 2u; }
    const size_t kstep = (size_t)(BK * 2);
    const size_t hstepA = (size_t)HALF * g.lda * 2, hstepB = (size_t)HALF * g.ldb * 2;
    const size_t tstepA = 2 * hstepA, tstepB = 2 * hstepB;
    const unsigned ldsw = (unsigned)wid * 1024u;
    const int aoff = lds_byte(wr * 64 + fr, fq * 8), boff = lds_byte(wc * 32 + fr, fq * 8);
#define PG8_SA(b, h) (((b) * 2 + (h)) * HTB)
#define PG8_SB(b, h) ((4 + (b) * 2 + (h)) * HTB)
#define PG8_STAGE(bufoff, gbase, voff) do { _Pragma("unroll") for (int _i = 0; _i < 2; ++_i) \
        __builtin_amdgcn_global_load_lds((const unsigned*)((const char*)(gbase) + (voff)[_i]), (PG8_LAS unsigned*)(lds + (bufoff) + ldsw + _i * 8192), 16, 0, 0); } while (0)
#define PG8_LDA(dst, b, h) do { _Pragma("unroll") for (int m = 0; m < 4; ++m) _Pragma("unroll") for (int k = 0; k < 2; ++k) dst[m][k] = *(const PG8_LAS bf16x8*)(lds + PG8_SA(b, h) + aoff + m * 2048 + k * 1024); } while (0)
#define PG8_LDB(dst, b, h) do { _Pragma("unroll") for (int n = 0; n < 2; ++n) _Pragma("unroll") for (int k = 0; k < 2; ++k) dst[n][k] = *(const PG8_LAS bf16x8*)(lds + PG8_SB(b, h) + boff + n * 2048 + k * 1024); } while (0)
#define PG8_MMA(ai, bj, At, Bt) do { __builtin_amdgcn_s_setprio(1); _Pragma("unroll") for (int m = 0; m < 4; ++m) _Pragma("unroll") for (int n = 0; n < 2; ++n) _Pragma("unroll") for (int k = 0; k < 2; ++k) \
        acc[ai][bj][m][n] = __builtin_amdgcn_mfma_f32_16x16x32_bf16(Bt[n][k], At[m][k], acc[ai][bj][m][n], 0, 0, 0); __builtin_amdgcn_s_setprio(0); } while (0)
#define PG8_WAIT_V(n) asm volatile("s_waitcnt vmcnt(" #n ")" ::: "memory")
#define PG8_WAIT_L(n) asm volatile("s_waitcnt lgkmcnt(" #n ")" ::: "memory")
#define PG8_BAR __builtin_amdgcn_s_barrier()
#define PG8_SCHED __builtin_amdgcn_sched_barrier(0)
    Unit cur, nxt; int ui = 0;
    if (!S.next(0, cur)) return;
    f32x4 acc[2][2][4][2];
#pragma unroll
    for (int a = 0; a < 2; ++a)
#pragma unroll
        for (int b = 0; b < 2; ++b)
#pragma unroll
            for (int m = 0; m < 4; ++m)
#pragma unroll
                for (int n = 0; n < 2; ++n) acc[a][b][m][n] = (f32x4){0.f, 0.f, 0.f, 0.f};
    bf16x8 At[4][2], B0[2][2], B1[2][2];
    const char* cA = (const char*)g.A + (size_t)cur.pm * tstepA + (size_t)cur.koff * 2; const char* cB = (const char*)g.Bt + (size_t)cur.pn * tstepB + (size_t)cur.koff * 2;
    S.a_ready(cur);
    if constexpr (SP2) {
        PG8_STAGE(PG8_SB(0, 0), cB, voffB); PG8_STAGE(PG8_SB(0, 1), cB + hstepB, voffB); PG8_STAGE(PG8_SA(0, 0), cA, voffA); PG8_STAGE(PG8_SA(0, 1), cA + hstepA, voffA);
        if (wr == 1) PG8_BAR;
        PG8_WAIT_V(2); PG8_BAR;
        PG8_STAGE(PG8_SB(1, 0), cB + kstep, voffB); PG8_STAGE(PG8_SA(1, 0), cA + kstep, voffA); PG8_STAGE(PG8_SB(1, 1), cB + hstepB + kstep, voffB);
        PG8_WAIT_V(6); PG8_BAR;
    } else {
        PG8_STAGE(PG8_SB(0, 0), cB, voffB); PG8_STAGE(PG8_SA(0, 0), cA, voffA); PG8_STAGE(PG8_SB(0, 1), cB + hstepB, voffB); PG8_STAGE(PG8_SA(0, 1), cA + hstepA, voffA);
        if (wr == 1) PG8_BAR;
        PG8_WAIT_V(4); PG8_BAR;
        PG8_STAGE(PG8_SB(1, 0), cB + kstep, voffB); PG8_STAGE(PG8_SA(1, 0), cA + kstep, voffA); PG8_STAGE(PG8_SB(1, 1), cB + hstepB + kstep, voffB);
        PG8_WAIT_V(6); PG8_BAR;
    }
    for (;;) {
        const bool has_next = S.next(ui + 1, nxt);
        const char* nA = has_next ? (const char*)g.A + (size_t)nxt.pm * tstepA + (size_t)nxt.koff * 2 : cA; const char* nB = has_next ? (const char*)g.Bt + (size_t)nxt.pn * tstepB + (size_t)nxt.koff * 2 : cB;
        for (int t = 0; t < nt; t += 2) {
            const bool last = (t == nt - 2);
            const char* a1 = cA + (size_t)(t + 1) * kstep;
            const char* a2 = last ? nA : cA + (size_t)(t + 2) * kstep; const char* b2 = last ? nB : cB + (size_t)(t + 2) * kstep;
            const char* a3 = a2 + kstep; const char* b3 = b2 + kstep;
            if (last && has_next) S.a_ready(nxt);
            if constexpr (SP2) {
            PG8_LDB(B0, 0, 0); PG8_LDB(B1, 0, 1); PG8_SCHED; PG8_LDA(At, 0, 0); PG8_STAGE(PG8_SA(1, 1), a1 + hstepA, voffA);
            PG8_WAIT_V(8); PG8_WAIT_L(0); PG8_BAR; PG8_MMA(0, 0, At, B0); PG8_MMA(0, 1, At, B1); PG8_BAR; PG8_SCHED;
            PG8_LDA(At, 0, 1); PG8_STAGE(PG8_SB(0, 0), b2, voffB); PG8_STAGE(PG8_SB(0, 1), b2 + hstepB, voffB); PG8_STAGE(PG8_SA(0, 0), a2, voffA);
            PG8_WAIT_V(8); PG8_WAIT_L(0); PG8_BAR; PG8_MMA(1, 0, At, B0); PG8_MMA(1, 1, At, B1); PG8_BAR; PG8_SCHED;
            PG8_LDB(B0, 1, 0); PG8_LDB(B1, 1, 1); PG8_SCHED; PG8_LDA(At, 1, 0); PG8_STAGE(PG8_SA(0, 1), a2 + hstepA, voffA);
            PG8_WAIT_V(8); PG8_WAIT_L(0); PG8_BAR; PG8_MMA(0, 0, At, B0); PG8_MMA(0, 1, At, B1); PG8_BAR; PG8_SCHED;
            PG8_LDA(At, 1, 1); PG8_STAGE(PG8_SB(1, 0), b3, voffB); PG8_STAGE(PG8_SB(1, 1), b3 + hstepB, voffB); PG8_STAGE(PG8_SA(1, 0), a3, voffA);
            PG8_WAIT_V(8); PG8_WAIT_L(0); PG8_BAR; PG8_MMA(1, 0, At, B0); PG8_MMA(1, 1, At, B1); PG8_BAR; PG8_SCHED;
            } else {
            PG8_LDB(B0, 0, 0); PG8_SCHED; PG8_LDA(At, 0, 0); PG8_STAGE(PG8_SA(1, 1), a1 + hstepA, voffA);
            PG8_WAIT_L(8); PG8_BAR; PG8_WAIT_L(0); PG8_MMA(0, 0, At, B0); PG8_BAR; PG8_SCHED;
            PG8_LDB(B1, 0, 1); PG8_STAGE(PG8_SB(0, 0), b2, voffB);
            PG8_BAR; PG8_WAIT_L(0); PG8_MMA(0, 1, At, B1); PG8_BAR;
            PG8_LDA(At, 0, 1); PG8_STAGE(PG8_SA(0, 0), a2, voffA);
            PG8_BAR; PG8_WAIT_L(0); PG8_MMA(1, 0, At, B0); PG8_BAR; PG8_SCHED;
            PG8_STAGE(PG8_SB(0, 1), b2 + hstepB, voffB);
            PG8_WAIT_V(6); PG8_BAR; PG8_MMA(1, 1, At, B1); PG8_BAR;
            PG8_LDB(B0, 1, 0); PG8_SCHED; PG8_LDA(At, 1, 0); PG8_STAGE(PG8_SA(0, 1), a2 + hstepA, voffA);
            PG8_WAIT_L(8); PG8_BAR; PG8_WAIT_L(0); PG8_MMA(0, 0, At, B0); PG8_BAR; PG8_SCHED;
            PG8_LDB(B1, 1, 1); PG8_STAGE(PG8_SB(1, 0), b3, voffB);
            PG8_BAR; PG8_WAIT_L(0); PG8_MMA(0, 1, At, B1); PG8_BAR;
            PG8_LDA(At, 1, 1); PG8_STAGE(PG8_SA(1, 0), a3, voffA);
            PG8_BAR; PG8_WAIT_L(0); PG8_MMA(1, 0, At, B0); PG8_BAR; PG8_SCHED;
            PG8_STAGE(PG8_SB(1, 1), b3 + hstepB, voffB);
            PG8_WAIT_V(6); PG8_BAR; PG8_MMA(1, 1, At, B1); PG8_BAR;
            }
        }
        if constexpr (ALIGN_EPI) { if (wr == 0) PG8_BAR; }
        if constexpr (!Epi::AFTER_DRAIN) { E(acc, cur, wr, wc, fr, fq); S.done(cur); }
        if (!has_next) break;
        if (cur.seg == Epi::NSEG - 1)
#pragma unroll
        for (int a = 0; a < 2; ++a)
#pragma unroll
            for (int b = 0; b < 2; ++b)
#pragma unroll
                for (int m = 0; m < 4; ++m)
#pragma unroll
                    for (int n = 0; n < 2; ++n) acc[a][b][m][n] = (f32x4){0.f, 0.f, 0.f, 0.f};
        cur = nxt; cA = nA; cB = nB; ++ui;
        if constexpr (ALIGN_EPI) { if (wr == 1) PG8_BAR; }
    }
    PG8_WAIT_V(0);
    if constexpr (!ALIGN_EPI) { if (wr == 0) PG8_BAR; }
    PG8_BAR;
    if constexpr (Epi::AFTER_DRAIN) { E.fused(acc, cur, wr, wc, fr, fq, lds, wid, lane); S.done(cur); }
#undef PG8_SA
#undef PG8_SB
#undef PG8_STAGE
#undef PG8_LDA
#undef PG8_LDB
#undef PG8_MMA
#undef PG8_WAIT_V
#undef PG8_WAIT_L
#undef PG8_BAR
#undef PG8_SCHED
}

}

constexpr int NWAVES = 8;
constexpr int DM = 2048, MP = 32768, MS = 1024, M = MP + MS;
constexpr int SEQ = 4096, PAST = 4096, DSEQ = 64, NB_P = 8, NB_S = 16;
constexpr int IN_W = 12880;
constexpr int N1A = 6912, N1B = 6144;
constexpr int C_Q = 0, C_K = 1024, C_V = 1280, C_IQ = 1536, C_IK = 2560, C_IW = 2624, C_GA = 2640, C_U = 3664, C_BGT = 4176, C_CG = 4688, C_GB = 5200, C_PIN = 5712, C_GC = 6224, C_MA = 6736;
constexpr float EPS = 1e-6f;
constexpr int SLD = 4224;
constexpr int MW = 66;
constexpr int N_ATT_ITEMS = 16 + 512, N_CP_ITEMS = M / 64, N_ITEMS = N_ATT_ITEMS + N_CP_ITEMS;

constexpr size_t MiB = 1u << 20;
constexpr size_t al256(size_t x) { return (x + 255) / 256 * 256; }
constexpr size_t WS_CTL = 0, CTL_ZERO_BYTES = 1 * MiB;
constexpr size_t WS_W1A = 1 * MiB;
constexpr size_t WS_W1B = WS_W1A + (size_t)N1A * DM * 2;
constexpr size_t WS_WL = WS_W1B + (size_t)N1B * DM * 2;
constexpr size_t WS_WO = WS_WL + (size_t)DM * DM * 2;
constexpr size_t WS_PW = WS_WO + (size_t)DM * DM * 2;
constexpr size_t WS_H = al256(WS_PW + 4 * 128 * 128 * 2);
constexpr size_t WS_Y = WS_H + (size_t)M * DM * 2;
constexpr size_t WS_Q = WS_Y + (size_t)M * DM * 2;
constexpr size_t WS_K = WS_Q + (size_t)M * 1024 * 2;
constexpr size_t WS_V = WS_K + (size_t)M * 256 * 2;
constexpr size_t WS_IQ = WS_V + (size_t)M * 256 * 2;
constexpr size_t WS_IK = WS_IQ + (size_t)M * 1024 * 2;
constexpr size_t WS_IW = WS_IK + (size_t)M * 64 * 2;
constexpr size_t WS_CIN = WS_IW + (size_t)M * 16 * 4;
constexpr size_t WS_PIN = WS_CIN + (size_t)M * 512 * 2;
constexpr size_t WS_CK = WS_PIN + (size_t)M * 512 * 2;
constexpr size_t WS_CV = WS_CK + (size_t)NB_S * PAST * 256 * 2;
constexpr size_t WS_CIK = WS_CV + (size_t)NB_S * PAST * 256 * 2;
constexpr size_t WS_S = WS_CIK + (size_t)NB_S * PAST * 64 * 2;
constexpr size_t S_WG_BYTES = (size_t)64 * SLD * 4;
constexpr size_t WS_S_END = WS_S + 256 * S_WG_BYTES;
constexpr size_t WS_G = WS_Q;
constexpr size_t WS_END = WS_S_END;
static_assert(WS_G + (size_t)M * N1B * 2 <= WS_END, "G overlay fits");
static_assert(WS_END <= (size_t)1024 * MiB, "workspace map must fit 1 GiB");
constexpr int CW_BAR = 4096;
constexpr int CW_QUEUE = 8192;

constexpr int RING_BYTES = 131072;
constexpr int LDS_BYTES = 155648;
constexpr int LDSCTL_OFF = LDS_BYTES - 1024, MISC_OFF = LDSCTL_OFF + 320;

#define GAS __attribute__((address_space(1)))
#define LAS __attribute__((address_space(3)))
typedef unsigned short bf16;
typedef unsigned v4u __attribute__((ext_vector_type(4)));
typedef unsigned v2u __attribute__((ext_vector_type(2)));
typedef float f32x4 __attribute__((ext_vector_type(4)));
typedef float f32x16 __attribute__((ext_vector_type(16)));
typedef short bf16x8 __attribute__((ext_vector_type(8)));
typedef short s16x4 __attribute__((ext_vector_type(4)));
#define LDS_WAIT() asm volatile("s_waitcnt lgkmcnt(0)" ::: "memory")
#define VM_WAIT() asm volatile("s_waitcnt vmcnt(0)" ::: "memory")
using pg8::cvt_pk_bf16;
__device__ __forceinline__ float bf2f(unsigned short b) { return __builtin_bit_cast(float, (unsigned)b << 16); }
__device__ __forceinline__ float bflo(unsigned w) { return __builtin_bit_cast(float, w << 16); }
__device__ __forceinline__ float bfhi(unsigned w) { return __builtin_bit_cast(float, w & 0xffff0000u); }
__device__ __forceinline__ v4u pack8(const float (&v)[8]) { v4u w; w.x = cvt_pk_bf16(v[0], v[1]); w.y = cvt_pk_bf16(v[2], v[3]); w.z = cvt_pk_bf16(v[4], v[5]); w.w = cvt_pk_bf16(v[6], v[7]); return w; }
__device__ __forceinline__ void unpack8(v4u w, float (&v)[8]) { v[0] = bflo(w.x); v[1] = bfhi(w.x); v[2] = bflo(w.y); v[3] = bfhi(w.y); v[4] = bflo(w.z); v[5] = bfhi(w.z); v[6] = bflo(w.w); v[7] = bfhi(w.w); }
__device__ __forceinline__ float sigmoidf_(float x) { return __builtin_amdgcn_rcpf(1.0f + __builtin_amdgcn_exp2f(-1.4426950408889634f * x)); }
__device__ __forceinline__ float siluf_(float x) { return x * sigmoidf_(x); }
__device__ __forceinline__ float wave_sum(float v) {
#pragma unroll
    for (int o = 1; o < 64; o <<= 1) v += __shfl_xor(v, o);
    return v;
}

#define XB_TMO      128
#define XB_XCNT(j)  (256  + 64 * (j))
#define XB_XSUB(j)  (1280 + 64 * (j))
#define XB_XGEN(j)  (2304 + 64 * (j))
#define XB_TOP      3328
#define XB_TOPGEN   3392
#define XCD_BAR_WORDS 3456
#define XB_SPIN_CAP (1u << 18)

__device__ __forceinline__ unsigned xb_ld(unsigned* p)              { return __hip_atomic_load(p, __ATOMIC_RELAXED, __HIP_MEMORY_SCOPE_AGENT); }
__device__ __forceinline__ unsigned xb_add(unsigned* p, unsigned v) { return __hip_atomic_fetch_add(p, v, __ATOMIC_RELAXED, __HIP_MEMORY_SCOPE_AGENT); }
__device__ __forceinline__ unsigned xb_xcc_id() { return (unsigned)__builtin_amdgcn_s_getreg((3 << 11) | 20) & 0xFu; }
#define XB_SPIN(cond, bar) do { unsigned _sp = 0; while (cond) { __builtin_amdgcn_s_sleep(1); \
    if ((++_sp & 255u) == 0u) { if (xb_ld(&(bar)[XB_TMO])) break; if (_sp > XB_SPIN_CAP) { atomicAdd(&(bar)[XB_TMO], 1u); break; } } } } while (0)

struct XcdBarrier {
    unsigned* bar; unsigned x;
    volatile LAS unsigned* st;
};

__device__ __forceinline__ XcdBarrier xcd_barrier_post(unsigned* bar, volatile LAS unsigned* st) {
    XcdBarrier b; b.bar = bar; b.x = xb_xcc_id(); b.st = st;
    if (threadIdx.x == 0) (void)xb_add(&bar[XB_XCNT(b.x)], 1u);
    return b;
}
__device__ __forceinline__ void xcd_barrier_complete(unsigned* bar, unsigned x, unsigned& nloc, unsigned& nx) {
    const unsigned G = gridDim.x * gridDim.y * gridDim.z;
    unsigned sum, cnt, mine, sp = 0u;
    for (;;) {
        sum = 0u; cnt = 0u; mine = 0u;
#pragma unroll
        for (unsigned j = 0; j < 16; ++j) { const unsigned c = xb_ld(&bar[XB_XCNT(j)]); sum += c; cnt += (c > 0u) ? 1u : 0u; mine = (j == x) ? c : mine; }
        if (sum == G) break;
        __builtin_amdgcn_s_sleep(1);
        if ((++sp & 255u) == 0u) { if (xb_ld(&bar[XB_TMO])) break; if (sp > XB_SPIN_CAP) { atomicAdd(&bar[XB_TMO], 1u); break; } }
    }
    nloc = mine > 0u ? mine : 1u; nx = cnt > 0u ? cnt : 1u;
}

__device__ __forceinline__ void xcd_barrier(const XcdBarrier& b) {
    asm volatile("s_waitcnt vmcnt(0)" ::: "memory");
    __syncthreads();
    if (threadIdx.x == 0) {
        unsigned* bar = b.bar;
        __builtin_amdgcn_s_waitcnt(0);
        unsigned nloc = b.st[0], nx = b.st[1];
        if (nloc == 0u) { xcd_barrier_complete(bar, b.x, nloc, nx); b.st[0] = nloc; b.st[1] = nx; }
        const unsigned old = xb_add(&bar[XB_XSUB(b.x)], 1u);
        const unsigned gen = old / nloc;
        if (old + 1u == (gen + 1u) * nloc) {
            __builtin_amdgcn_fence(__ATOMIC_RELEASE, "agent");
            asm volatile("s_waitcnt vmcnt(0)" ::: "memory");
            const unsigned og = xb_add(&bar[XB_TOP], 1u);
            const unsigned tg = og / nx;
            if (og + 1u == (tg + 1u) * nx) xb_add(&bar[XB_TOPGEN], 1u);
            else XB_SPIN(xb_ld(&bar[XB_TOPGEN]) == tg, bar);
            __builtin_amdgcn_fence(__ATOMIC_ACQUIRE, "agent");
            xb_add(&bar[XB_XGEN(b.x)], 1u);
            asm volatile("s_waitcnt vmcnt(0)" ::: "memory");
        } else {
            XB_SPIN(xb_ld(&bar[XB_XGEN(b.x)]) == gen, bar);
            __builtin_amdgcn_fence(__ATOMIC_ACQUIRE, "agent");
            asm volatile("s_waitcnt vmcnt(0)" ::: "memory");
        }
    }
    __syncthreads();
}


struct Args {
    const float* x_prompt; const float* x_sample; const float* cache_k; const float* cache_v; const float* cache_ik; const float* state_conv; const float* state_pool;
    const float* norm_g; const float* w_in; const float* conv_w; const float* conv_b; const float* pool_w; const float* pool_scale;
    const float* lift_a; const float* lift_b; const float* lift_c; const float* w_out; const float* final_g;
    float* out; unsigned char* ws;
};
struct Frame {
    LAS unsigned char* lds; volatile LAS unsigned* MISC; unsigned* ctl;
    int tid, lane, wave, vcu, G;
};
constexpr size_t O_Y = 0, O_KP = (size_t)M * DM, O_VP = O_KP + (size_t)2 * MP * 256, O_IKP = O_VP + (size_t)2 * MP * 256, O_CP = O_IKP + (size_t)2 * MP * 64, O_PP = O_CP + (size_t)2 * 8 * 2 * 512,
                 O_KS = O_PP + (size_t)2 * 8 * 15 * 512, O_VS = O_KS + (size_t)2 * MS * 256, O_IKS = O_VS + (size_t)2 * MS * 256, O_CS = O_IKS + (size_t)2 * MS * 64, O_PS = O_CS + (size_t)2 * 16 * 2 * 512, O_END = O_PS + (size_t)2 * 16 * 15 * 512;

__device__ const float c_inv[64] = { 1.0f, 0.8659643530845642f, 0.7498942017555237f, 0.6493816375732422f, 0.5623413324356079f, 0.486967533826828f, 0.4216965138912201f, 0.3651741147041321f, 0.3162277638912201f, 0.2738419771194458f, 0.23713737726211548f, 0.20535250008106232f, 0.17782793939113617f, 0.1539926528930664f, 0.1333521455526352f, 0.11547819525003433f, 0.10000000149011612f, 0.08659642934799194f, 0.0749894231557846f, 0.06493816524744034f, 0.05623413249850273f, 0.04869675263762474f, 0.04216964915394783f, 0.03651741147041321f, 0.03162277489900589f, 0.0273841954767704f, 0.023713737726211548f, 0.02053525112569332f, 0.017782794311642647f, 0.015399265103042126f, 0.013335213996469975f, 0.011547819711267948f, 0.009999999776482582f, 0.00865964312106371f, 0.007498942315578461f, 0.006493816152215004f, 0.005623413249850273f, 0.004869675263762474f, 0.0042169648222625256f, 0.0036517411936074495f, 0.003162277629598975f, 0.0027384196873754263f, 0.0023713738191872835f, 0.0020535250660032034f, 0.0017782794311642647f, 0.0015399265103042126f, 0.0013335214462131262f, 0.0011547820176929235f, 0.0010000000474974513f, 0.0008659643353894353f, 0.0007498941849917173f, 0.0006493816035799682f, 0.000562341301701963f, 0.0004869675321970135f, 0.0004216965171508491f, 0.00036517411353997886f, 0.0003162277571391314f, 0.00027384195709601045f, 0.00023713737027719617f, 0.00020535250951070338f, 0.00017782794020604342f, 0.0001539926597615704f, 0.0001333521504420787f, 0.00011547820031410083f };

__device__ __forceinline__ void sincos_rev(float ang, float& s, float& c) {
    float r = ang * 0.15915494309189535f; r = __builtin_amdgcn_fractf(r); s = __builtin_amdgcn_sinf(r); c = __builtin_amdgcn_cosf(r);
}

__device__ __forceinline__ int colmap_a(int np) {
    const int pn = np >> 8, jj = np & 255, half = jj >> 7, j = jj & 127;
    if (pn < 4)  return C_Q + (2 * pn + (j >> 6)) * 128 + (j & 63) + 64 * half;
    if (pn == 4) return C_K + (j >> 6) * 128 + (j & 63) + 64 * half;
    if (pn == 5) return C_V + jj;
    if (pn < 10) return C_IQ + (4 * (pn - 6) + (j >> 5)) * 64 + (j & 31) + 32 * half;
    if (pn == 10) { if (j < 32) return C_IK + j + 32 * half; if (half == 0 && j < 48) return C_IW + (j - 32); return -1; }
    if (pn < 15) return C_GA + (pn - 11) * 256 + jj;
    if (pn < 19) return (half ? C_CG : C_U) + (pn - 15) * 128 + j;
    if (pn < 23) return (half ? C_GB : C_BGT) + (pn - 19) * 128 + j;
    return (half ? C_GC : C_PIN) + (pn - 23) * 128 + j;
}
__device__ __forceinline__ void transpose_item(const float* W, int ldw, bf16* WT, int ldd, int koff, int k0, int n0, int src, LAS float* scr, int lane) {
#pragma unroll 8
    for (int i = 0; i < 32; ++i) { const int kk = 2 * i + (lane >> 5); scr[kk * 33 + (lane & 31)] = src >= 0 ? W[(size_t)(k0 + kk) * ldw + src] : 0.f; }
    LDS_WAIT(); asm volatile("" ::: "memory");
    const int c = lane & 7;
#pragma unroll
    for (int j = 0; j < 4; ++j) { const int n = (lane >> 3) + 8 * j; const LAS float* s = scr + (8 * c) * 33 + n;
        v4u o; o.x = cvt_pk_bf16(s[0 * 33], s[1 * 33]); o.y = cvt_pk_bf16(s[2 * 33], s[3 * 33]); o.z = cvt_pk_bf16(s[4 * 33], s[5 * 33]); o.w = cvt_pk_bf16(s[6 * 33], s[7 * 33]);
        *(GAS v4u*)(WT + (size_t)(n0 + n) * ldd + koff + k0 + 8 * c) = o; }
    LDS_WAIT(); asm volatile("" ::: "memory");
}
__device__ __forceinline__ void cvt_stream(const float* src, bf16* dst, size_t n8, size_t i0, size_t stride) {
    for (size_t i = i0; i < n8; i += stride) { const f32x4 a = *(const GAS f32x4*)(src + i * 8), b = *(const GAS f32x4*)(src + i * 8 + 4);
        v4u o; o.x = cvt_pk_bf16(a[0], a[1]); o.y = cvt_pk_bf16(a[2], a[3]); o.z = cvt_pk_bf16(b[0], b[1]); o.w = cvt_pk_bf16(b[2], b[3]); *(GAS v4u*)(dst + i * 8) = o; }
}
template <bool OUT_BF16> __device__ __forceinline__ void rmsnorm_row(const float* xrow, const float* g, void* orow, int lane) {
    const GAS f32x4* xr = (const GAS f32x4*)xrow + lane; const GAS f32x4* gr = (const GAS f32x4*)g + lane;
    f32x4 v[8]; float s = 0.f;
#pragma unroll
    for (int j = 0; j < 8; ++j) { v[j] = xr[64 * j]; s += (v[j].x * v[j].x + v[j].y * v[j].y) + (v[j].z * v[j].z + v[j].w * v[j].w); }
    const float rstd = 1.0f / sqrtf(wave_sum(s) * (1.0f / DM) + EPS);
#pragma unroll
    for (int j = 0; j < 8; ++j) { const f32x4 gg = gr[64 * j]; const f32x4 y = v[j] * rstd * gg;
        if constexpr (OUT_BF16) { v2u o; o.x = cvt_pk_bf16(y.x, y.y); o.y = cvt_pk_bf16(y.z, y.w); ((GAS v2u*)orow)[lane + 64 * j] = o; }
        else ((GAS f32x4*)orow)[lane + 64 * j] = y; }
}
__device__ __forceinline__ void p0_prologue(const Frame& F, const Args& A, int l, const float* xp, const float* xs) {
    int tid = F.tid; asm volatile("" : "+v"(tid));
    const int lane = tid & 63, wave = __builtin_amdgcn_readfirstlane(tid >> 6);
    LAS float* scr = (LAS float*)(F.lds + wave * 16384);
    const int gw = F.vcu * NWAVES + wave, NGW = F.G * NWAVES;
    unsigned char* ws = A.ws;
    constexpr int I_A = 32 * (N1A / 32), I_B = 32 * (N1B / 32), I_LA = 16 * 64, I_LB = 8 * 64, I_LC = 8 * 64, I_O = 32 * 64, I_P = 4 * 2 * 4;
    constexpr int NIT = I_A + I_B + I_LA + I_LB + I_LC + I_O + I_P;
    for (int it = gw; it < NIT; it += NGW) {
        int r = it;
        if (r < I_A) { const int kb = r / (N1A / 32), nb = r % (N1A / 32); transpose_item(A.w_in + (size_t)l * DM * IN_W, IN_W, (bf16*)(ws + WS_W1A), DM, 0, 64 * kb, 32 * nb, colmap_a(32 * nb + (lane & 31)), scr, lane); continue; } r -= I_A;
        if (r < I_B) { const int kb = r / (N1B / 32), nb = r % (N1B / 32); transpose_item(A.w_in + (size_t)l * DM * IN_W, IN_W, (bf16*)(ws + WS_W1B), DM, 0, 64 * kb, 32 * nb, C_MA + 32 * nb + (lane & 31), scr, lane); continue; } r -= I_B;
        if (r < I_LA) { const int kb = r / 64, nb = r % 64; transpose_item(A.lift_a + (size_t)l * 1024 * DM, DM, (bf16*)(ws + WS_WL), DM, 0, 64 * kb, 32 * nb, 32 * nb + (lane & 31), scr, lane); continue; } r -= I_LA;
        if (r < I_LB) { const int kb = r / 64, nb = r % 64; transpose_item(A.lift_b + (size_t)l * 512 * DM, DM, (bf16*)(ws + WS_WL), DM, 1024, 64 * kb, 32 * nb, 32 * nb + (lane & 31), scr, lane); continue; } r -= I_LB;
        if (r < I_LC) { const int kb = r / 64, nb = r % 64; transpose_item(A.lift_c + (size_t)l * 512 * DM, DM, (bf16*)(ws + WS_WL), DM, 1536, 64 * kb, 32 * nb, 32 * nb + (lane & 31), scr, lane); continue; } r -= I_LC;
        if (r < I_O) { const int kb = r / 64, nb = r % 64; transpose_item(A.w_out + (size_t)l * DM * DM, DM, (bf16*)(ws + WS_WO), DM, 0, 64 * kb, 32 * nb, 32 * nb + (lane & 31), scr, lane); continue; } r -= I_O;
        { const int g = r / 8, kb = (r % 8) / 4, nb = r % 4; transpose_item(A.pool_w + (size_t)(l * 4 + g) * 128 * 128, 128, (bf16*)(ws + WS_PW) + g * 128 * 128, 128, 0, 64 * kb, 32 * nb, 32 * nb + (lane & 31), scr, lane); }
    }
    {
        const size_t i0 = (size_t)gw * 64 + lane, st = (size_t)NGW * 64;
        cvt_stream(A.cache_k + (size_t)l * NB_S * PAST * 256, (bf16*)(ws + WS_CK), (size_t)NB_S * PAST * 256 / 8, i0, st);
        cvt_stream(A.cache_v + (size_t)l * NB_S * PAST * 256, (bf16*)(ws + WS_CV), (size_t)NB_S * PAST * 256 / 8, i0, st);
        cvt_stream(A.cache_ik + (size_t)l * NB_S * PAST * 64, (bf16*)(ws + WS_CIK), (size_t)NB_S * PAST * 64 / 8, i0, st);
    }
    const float* g = A.norm_g + (size_t)l * DM; bf16* H = (bf16*)(ws + WS_H);
    for (int m = gw; m < M; m += NGW) rmsnorm_row<true>(m < MP ? xp + (size_t)m * DM : xs + (size_t)(m - MP) * DM, g, H + (size_t)m * DM, lane);
}

typedef pg8::Unit Unit;
#define ACCV(ai, bj, m, i) acc[ai][bj][m][(i) >> 2][(i) & 3]
__device__ __forceinline__ void st_f32x8(float* p, const float (&v)[8]) { *(GAS f32x4*)p = (f32x4){v[0], v[1], v[2], v[3]}; *(GAS f32x4*)(p + 4) = (f32x4){v[4], v[5], v[6], v[7]}; }
__device__ __forceinline__ void st_bf16x8(bf16* p, const float (&v)[8]) { *(GAS v4u*)p = pack8(v); }

struct EpiP1 {
    static constexpr bool PERM = true, AFTER_DRAIN = false; static constexpr int NSEG = 1;
    bf16 *Qb, *Kb, *Vb, *IQb, *IKb, *Y, *CIN, *PIN; float* IW;
    float *k_p, *k_s, *v_p, *v_s, *ik_p, *ik_s, *cv_p, *cv_s, *pl_p, *pl_s;
    __device__ __forceinline__ void operator()(const f32x4 (&acc)[2][2][4][2], const Unit& u, int wr, int wc, int fr, int fq) const {
        asm volatile("" : "+v"(fr), "+v"(fq));
        const int pn = u.pn; const bool smp = u.pm >= MP / 256;
        const int rbase = u.pm * 256 + wr * 64 + fr, j0 = wc * 32 + fq * 8;
        if (pn <= 4 || (pn >= 6 && pn <= 9) || (pn == 10 && wc == 0)) {
            const bool idx = pn >= 6; float inv[8];
#pragma unroll
            for (int i = 0; i < 8; ++i) inv[i] = idx ? c_inv[2 * ((j0 & 31) + i)] : c_inv[(j0 & 63) + i];
#pragma unroll
            for (int ai = 0; ai < 2; ++ai)
#pragma unroll
                for (int m = 0; m < 4; ++m) {
                    const int row = rbase + ai * 128 + m * 16; const float pos = (float)(smp ? PAST + (row & 63) : (row & (SEQ - 1)));
                    float o1[8], o2[8];
#pragma unroll
                    for (int i = 0; i < 8; ++i) { float s, c; sincos_rev(pos * inv[i], s, c); const float x1 = ACCV(ai, 0, m, i), x2 = ACCV(ai, 1, m, i); o1[i] = x1 * c - x2 * s; o2[i] = x2 * c + x1 * s; }
                    if (pn < 4) { bf16* p = Qb + (size_t)row * 1024 + (2 * pn + (j0 >> 6)) * 128 + (j0 & 63); st_bf16x8(p, o1); st_bf16x8(p + 64, o2); }
                    else if (pn == 4) { const int off = (j0 >> 6) * 128 + (j0 & 63); bf16* p = Kb + (size_t)row * 256 + off; st_bf16x8(p, o1); st_bf16x8(p + 64, o2);
                        float* q = (smp ? k_s + (size_t)(row - MP) * 256 : k_p + (size_t)row * 256) + off; st_f32x8(q, o1); st_f32x8(q + 64, o2); }
                    else if (pn < 10) { bf16* p = IQb + (size_t)row * 1024 + (4 * (pn - 6) + (j0 >> 5)) * 64 + (j0 & 31); st_bf16x8(p, o1); st_bf16x8(p + 32, o2); }
                    else { bf16* p = IKb + (size_t)row * 64 + j0; st_bf16x8(p, o1); st_bf16x8(p + 32, o2);
                        float* q = (smp ? ik_s + (size_t)(row - MP) * 64 : ik_p + (size_t)row * 64) + j0; st_f32x8(q, o1); st_f32x8(q + 32, o2); }
                }
            return;
        }
#pragma unroll
        for (int ai = 0; ai < 2; ++ai)
#pragma unroll
            for (int m = 0; m < 4; ++m) {
                const int row = rbase + ai * 128 + m * 16; float a[8], b[8];
#pragma unroll
                for (int i = 0; i < 8; ++i) { a[i] = ACCV(ai, 0, m, i); b[i] = ACCV(ai, 1, m, i); }
                if (pn == 5) {
                    bf16* p = Vb + (size_t)row * 256 + j0; st_bf16x8(p, a); st_bf16x8(p + 128, b);
                    float* q = (smp ? v_s + (size_t)(row - MP) * 256 : v_p + (size_t)row * 256) + j0; st_f32x8(q, a); st_f32x8(q + 128, b);
                } else if (pn == 10) {
                    if (wc == 1 && fq < 2) { float* q = IW + (size_t)row * 16 + 8 * fq;
#pragma unroll
                        for (int i = 0; i < 8; ++i) a[i] *= 0.03125f;
                        st_f32x8(q, a); }
                } else if (pn < 15) {
#pragma unroll
                    for (int i = 0; i < 8; ++i) { a[i] = siluf_(a[i]); b[i] = siluf_(b[i]); }
                    bf16* p = Y + (size_t)row * DM + (pn - 11) * 256 + j0; st_bf16x8(p, a); st_bf16x8(p + 128, b);
                } else if (pn < 19) {
#pragma unroll
                    for (int i = 0; i < 8; ++i) a[i] *= b[i];
                    const int col = (pn - 15) * 128 + j0; st_bf16x8(CIN + (size_t)row * 512 + col, a);
                    const int t = smp ? (row & 63) : (row & (SEQ - 1)), T = smp ? DSEQ : SEQ;
                    if (t >= T - 2) { float* q = smp ? cv_s + ((size_t)((row - MP) >> 6) * 2 + (t - (T - 2))) * 512 + col : cv_p + ((size_t)(row >> 12) * 2 + (t - (T - 2))) * 512 + col; st_f32x8(q, a); }
                } else if (pn < 23) {
#pragma unroll
                    for (int i = 0; i < 8; ++i) a[i] *= siluf_(b[i]);
                    st_bf16x8(Y + (size_t)row * DM + 1024 + (pn - 19) * 128 + j0, a);
                } else {
                    const int col = (pn - 23) * 128 + j0; st_bf16x8(PIN + (size_t)row * 512 + col, a);
                    const int t = smp ? (row & 63) : (row & (SEQ - 1)), T = smp ? DSEQ : SEQ;
                    if (t >= T - 15) { float* q = smp ? pl_s + ((size_t)((row - MP) >> 6) * 15 + (t - (T - 15))) * 512 + col : pl_p + ((size_t)(row >> 12) * 15 + (t - (T - 15))) * 512 + col; st_f32x8(q, a); }
#pragma unroll
                    for (int i = 0; i < 8; ++i) b[i] = siluf_(b[i]);
                    st_bf16x8(Y + (size_t)row * DM + 1536 + col, b);
                }
            }
    }
};
struct EpiP3 {
    static constexpr bool PERM = true, AFTER_DRAIN = false; static constexpr int NSEG = 1;
    bf16* G;
    __device__ __forceinline__ void operator()(const f32x4 (&acc)[2][2][4][2], const Unit& u, int wr, int wc, int fr, int fq) const {
        asm volatile("" : "+v"(fr), "+v"(fq));
        const int rbase = u.pm * 256 + wr * 64 + fr, c0 = u.pn * 256 + wc * 32 + fq * 8;
#pragma unroll
        for (int ai = 0; ai < 2; ++ai)
#pragma unroll
            for (int m = 0; m < 4; ++m) { bf16* p = G + (size_t)(rbase + ai * 128 + m * 16) * N1B + c0;
#pragma unroll
                for (int bj = 0; bj < 2; ++bj) { float a[8];
#pragma unroll
                    for (int i = 0; i < 8; ++i) a[i] = sigmoidf_(ACCV(ai, bj, m, i));
                    st_bf16x8(p + bj * 128, a); } }
    }
};
struct EpiP4 {
    static constexpr bool PERM = true, AFTER_DRAIN = false; static constexpr int NSEG = 4;
    const bf16* G; bf16* Z;
    __device__ __forceinline__ void operator()(f32x4 (&acc)[2][2][4][2], const Unit& u, int wr, int wc, int fr, int fq) const {
        asm volatile("" : "+v"(fr), "+v"(fq));
        if (u.seg == 0) return;
        const int rbase = u.pm * 256 + wr * 64 + fr, c0 = u.pn * 256 + wc * 32 + fq * 8;
        if (u.seg < 3) {
            const int o1 = u.seg == 1 ? 0 : DM;
#pragma unroll
            for (int ai = 0; ai < 2; ++ai)
#pragma unroll
                for (int m = 0; m < 4; ++m) { const bf16* p = G + (size_t)(rbase + ai * 128 + m * 16) * N1B + c0 + o1;
#pragma unroll
                    for (int bj = 0; bj < 2; ++bj) { float ga[8], gb[8]; unpack8(*(const GAS v4u*)(p + bj * 128), ga); unpack8(*(const GAS v4u*)(p + bj * 128 + DM), gb);
#pragma unroll
                        for (int i = 0; i < 8; ++i) ACCV(ai, bj, m, i) *= ga[i] * __builtin_amdgcn_rcpf(gb[i]); } }
            return;
        }
#pragma unroll
        for (int ai = 0; ai < 2; ++ai)
#pragma unroll
            for (int m = 0; m < 4; ++m) { const int row = rbase + ai * 128 + m * 16; const bf16* p = G + (size_t)row * N1B + 2 * DM + c0;
#pragma unroll
                for (int bj = 0; bj < 2; ++bj) { float gc[8], a[8]; unpack8(*(const GAS v4u*)(p + bj * 128), gc);
#pragma unroll
                    for (int i = 0; i < 8; ++i) a[i] = ACCV(ai, bj, m, i) * gc[i];
                    st_bf16x8(Z + (size_t)row * DM + c0 + bj * 128, a); } }
    }
};
struct EpiP5 {
    static constexpr bool PERM = false, AFTER_DRAIN = false; static constexpr int NSEG = 1;
    const float* xp; const float* xs; float* out;
    __device__ __forceinline__ void operator()(const f32x4 (&acc)[2][2][4][2], const Unit& u, int wr, int wc, int fr, int fq) const {
        asm volatile("" : "+v"(fr), "+v"(fq));
        const int rbase = u.pm * 256 + wr * 64 + fr, c0 = u.pn * 256 + wc * 32 + 4 * fq;
#pragma unroll
        for (int ai = 0; ai < 2; ++ai)
#pragma unroll
            for (int m = 0; m < 4; ++m) { const int row = rbase + ai * 128 + m * 16;
                const float* xr = (row < MP ? xp + (size_t)row * DM : xs + (size_t)(row - MP) * DM) + c0; float* orow = out + (size_t)row * DM + c0;
#pragma unroll
                for (int bj = 0; bj < 2; ++bj)
#pragma unroll
                    for (int n = 0; n < 2; ++n) { const f32x4 xv = *(const GAS f32x4*)(xr + bj * 128 + n * 16); *(GAS f32x4*)(orow + bj * 128 + n * 16) = xv + acc[ai][bj][m][n]; } }
    }
};

#ifndef P2PARTS
#define P2PARTS 15
#endif
struct P2Ctx {
    const bf16 *Qb, *Kb, *Vb, *IQb, *IKb, *CKb, *CVb, *CIKb, *CIN, *PIN, *PWt; const float* IW; bf16* Y;
    const float *state_conv, *state_pool, *conv_w, *conv_b, *pool_scale;
    float* S;
};
struct AttnItem { int smp, b, m0, nt, ntp; };
constexpr int SHM_V = 64 * 128 * 2, SHM_K = 64 * 128 * 2, SHM_WS = 2 * SHM_V + 2 * SHM_K;
constexpr int ATT_W = SHM_WS + NWAVES * 256;
constexpr int ATT_QP = ATT_W + 64 * MW * 8;
#ifndef QPARK
#define QPARK 6
#endif
static_assert(ATT_QP + QPARK * 8192 <= LDSCTL_OFF, "attention LDS");
#define KSWZ(row, colB) ((row) * 256 + ((colB) ^ (((row) & 7) << 4)))
#define SBAR() __builtin_amdgcn_sched_barrier(0)
__device__ __forceinline__ int crow(int r, int hi) { return (r & 3) + 8 * (r >> 2) + 4 * hi; }
__device__ __forceinline__ bf16x8 ld8(const bf16* p) { return *reinterpret_cast<const bf16x8*>(p); }
__device__ __forceinline__ int voff(int row, int sc) { return (row >> 5) * 8192 + 2 * ((sc >> 4) * 512 + (row & 31) * 16 + (sc & 8)); }
__device__ __forceinline__ const bf16* kv_tile(const AttnItem& it, const bf16* newb, const bf16* cacheb, int kt, int pitch) {
    if (kt >= it.nt) kt = 0;
    if (it.smp) return kt < PAST / 64 ? cacheb + ((size_t)it.b * PAST + 64 * kt) * pitch : newb + (size_t)it.m0 * pitch;
    return newb + ((size_t)it.b * SEQ + 64 * kt) * pitch;
}
__device__ __forceinline__ unsigned wave_total_u32(unsigned v) {
    v += (unsigned)__builtin_amdgcn_update_dpp(0, (int)v, 0xB1, 0xF, 0xF, true);
    v += (unsigned)__builtin_amdgcn_update_dpp(0, (int)v, 0x4E, 0xF, 0xF, true);
    v += (unsigned)__builtin_amdgcn_update_dpp(0, (int)v, 0x141, 0xF, 0xF, true);
    v += (unsigned)__builtin_amdgcn_update_dpp(0, (int)v, 0x140, 0xF, 0xF, true);
    return (unsigned)__builtin_amdgcn_readlane((int)v, 0) + (unsigned)__builtin_amdgcn_readlane((int)v, 16) + (unsigned)__builtin_amdgcn_readlane((int)v, 32) + (unsigned)__builtin_amdgcn_readlane((int)v, 48);
}

__device__ __forceinline__ void a1_scores(char* shm, const AttnItem& it, const P2Ctx& C, int tid, int wid, int lane) {
    asm volatile("" : "+v"(tid)); lane = tid & 63; wid = __builtin_amdgcn_readfirstlane(tid >> 6);
    const int r32 = lane & 31, hi = lane >> 5;
    bf16x8 a[4][4]; float w[4][16];
#pragma unroll
    for (int p = 0; p < 4; ++p) {
        const int q = 8 * wid + 2 * p + ((r32 >> 2) & 1), head = 4 * (r32 >> 3) + (r32 & 3);
        const bf16* src = C.IQb + (size_t)(it.m0 + q) * 1024 + head * 64 + hi * 8;
#pragma unroll
        for (int ks = 0; ks < 4; ++ks) a[p][ks] = ld8(src + ks * 16);
        const float* wp = C.IW + (size_t)(it.m0 + 8 * wid + 2 * p + hi) * 16;
#pragma unroll
        for (int j = 0; j < 4; ++j) { const f32x4 t = *(const GAS f32x4*)(wp + 4 * j); w[p][4 * j] = t[0]; w[p][4 * j + 1] = t[1]; w[p][4 * j + 2] = t[2]; w[p][4 * j + 3] = t[3]; }
    }
    const int skey = tid >> 3, sch = tid & 7, sdst = skey * 128 + ((sch ^ ((skey >> 1) & 7)) << 4);
    v4u stg = *(const GAS v4u*)(kv_tile(it, C.IKb, C.CIKb, 0, 64) + skey * 64 + sch * 8);
    *(v4u*)(shm + sdst) = stg; __syncthreads();
    for (int kt = 0; kt < it.nt; ++kt) {
        const bool more = kt + 1 < it.nt;
        if (more) stg = *(const GAS v4u*)(kv_tile(it, C.IKb, C.CIKb, kt + 1, 64) + skey * 64 + sch * 8);
        const char* buf = shm + (kt & 1) * 8192;
#pragma unroll
        for (int ct = 0; ct < 2; ++ct) {
            const int key = 32 * ct + r32; bf16x8 b[4];
#pragma unroll
            for (int ks = 0; ks < 4; ++ks) b[ks] = *reinterpret_cast<const bf16x8*>(buf + key * 128 + (((2 * ks + hi) ^ ((key >> 1) & 7)) << 4));
#pragma unroll
            for (int p = 0; p < 4; ++p) {
                f32x16 c = {};
#pragma unroll
                for (int ks = 0; ks < 4; ++ks) c = __builtin_amdgcn_mfma_f32_32x32x16_bf16(a[p][ks], b[ks], c, 0, 0, 0);
                float s = 0.f;
#pragma unroll
                for (int r = 0; r < 16; ++r) s = fmaf(fmaxf(c[r], 0.f), w[p][r], s);
                C.S[(size_t)(8 * wid + 2 * p + hi) * SLD + 64 * kt + 32 * ct + r32] = s;
            }
        }
        if (more) *(v4u*)(shm + ((kt + 1) & 1) * 8192 + sdst) = stg;
        __syncthreads();
    }
}
template <int NREG> __device__ __forceinline__ void a2_select(const float* srow, int nt, LAS unsigned long long* Wq, int lane) {
    unsigned key[NREG];
#pragma unroll
    for (int i = 0; i < NREG; ++i) { const unsigned u = __builtin_nontemporal_load((const unsigned*)srow + 64 * i + lane);
        const unsigned k = u ^ ((unsigned)((int)u >> 31) | 0x80000000u); key[i] = i < nt ? k : 0u; }
    unsigned T = 0u, cntT = 0u;
#pragma unroll 1
    for (int bit = 31; bit >= 0; --bit) {
        const unsigned cand = T | (1u << bit); unsigned c = 0;
#pragma unroll
        for (int i = 0; i < NREG; ++i) c += key[i] >= cand ? 1u : 0u;
        c = wave_total_u32(c);
        if (c >= 256u) { T = cand; cntT = c; }
    }
    if (cntT == 256u) {
#pragma unroll
        for (int i = 0; i < NREG; ++i) { const unsigned long long m = __ballot(key[i] >= T); if (lane == 0 && i < nt) Wq[i] = m; }
    } else {
        unsigned g = 0;
#pragma unroll
        for (int i = 0; i < NREG; ++i) g += key[i] > T ? 1u : 0u;
        g = wave_total_u32(g);
        unsigned need = 256u - g, ceq = 0u;
#pragma unroll
        for (int i = 0; i < NREG; ++i) {
            const unsigned long long eq = __ballot(key[i] == T), gt = __ballot(key[i] > T);
            const unsigned rank = __builtin_amdgcn_mbcnt_hi((unsigned)(eq >> 32), __builtin_amdgcn_mbcnt_lo((unsigned)eq, 0u));
            const unsigned long long take = __ballot(key[i] == T && ceq + rank < need);
            if (lane == 0 && i < nt) Wq[i] = gt | take;
            ceq += (unsigned)__popcll(eq);
        }
    }
}
__device__ __forceinline__ void partialSM(f32x16& p0, f32x16& p1, float& m_reg, float& msub, float& alpha, unsigned long long wq, int hi) {
    constexpr float SL2E = 0.088388347648318447f * 1.4426950408889634f, THR2 = 8.0f * 1.4426950408889634f;
    const float ninf = -__builtin_inff(); const unsigned wlo = (unsigned)wq >> (4 * hi), whi = (unsigned)(wq >> 32) >> (4 * hi);
#pragma unroll
    for (int r = 0; r < 16; ++r) { const int c = (r & 3) + 8 * (r >> 2); p0[r] = ((wlo >> c) & 1u) ? p0[r] : ninf; p1[r] = ((whi >> c) & 1u) ? p1[r] : ninf; }
    float pmax = p0[0];
#pragma unroll
    for (int r = 1; r < 16; ++r) pmax = fmaxf(pmax, p0[r]);
#pragma unroll
    for (int r = 0; r < 16; ++r) pmax = fmaxf(pmax, p1[r]);
    { auto rr = __builtin_amdgcn_permlane32_swap(__float_as_uint(pmax), __float_as_uint(pmax), false, false); pmax = fmaxf(__uint_as_float(rr[0]), __uint_as_float(rr[1])); }
    pmax *= SL2E;
    if (__builtin_expect(__all(pmax - m_reg <= THR2), 1)) { alpha = 1.f; }
    else { float mn = fmaxf(m_reg, pmax); msub = (mn == -__builtin_inff()) ? 0.f : mn; alpha = __builtin_amdgcn_exp2f(m_reg - msub); m_reg = mn; }
    const float nm = -msub;
#pragma unroll
    for (int r = 0; r < 16; ++r) p0[r] = fmaf(p0[r], SL2E, nm);
#pragma unroll
    for (int r = 0; r < 16; ++r) p1[r] = fmaf(p1[r], SL2E, nm);
#pragma unroll
    for (int r = 0; r < 16; ++r) p0[r] = __builtin_amdgcn_exp2f(p0[r]);
}
__device__ __forceinline__ void finishSM(f32x16& p0, f32x16& p1, float alpha, float& l_reg, bf16x8& pa0, bf16x8& pa1, bf16x8& pa2, bf16x8& pa3) {
#pragma unroll
    for (int r = 0; r < 16; ++r) p1[r] = __builtin_amdgcn_exp2f(p1[r]);
    float ps = 0;
#pragma unroll
    for (int r = 0; r < 16; ++r) ps += p0[r];
#pragma unroll
    for (int r = 0; r < 16; ++r) ps += p1[r];
    { auto rr = __builtin_amdgcn_permlane32_swap(__float_as_uint(ps), __float_as_uint(ps), false, false); ps = __uint_as_float(rr[0]) + __uint_as_float(rr[1]); }
    l_reg = l_reg * alpha + ps;
#define PK4(P, BASE, OUT) do { unsigned a0 = cvt_pk_bf16(P[BASE + 0], P[BASE + 1]), a1 = cvt_pk_bf16(P[BASE + 2], P[BASE + 3]); \
    unsigned b0 = cvt_pk_bf16(P[BASE + 4], P[BASE + 5]), b1 = cvt_pk_bf16(P[BASE + 6], P[BASE + 7]); \
    auto r0 = __builtin_amdgcn_permlane32_swap(a0, b0, false, false); auto r1 = __builtin_amdgcn_permlane32_swap(a1, b1, false, false); \
    v4u w = {r0[0], r1[0], r0[1], r1[1]}; OUT = *reinterpret_cast<bf16x8*>(&w); } while (0)
    PK4(p0, 0, pa0); PK4(p0, 8, pa1); PK4(p1, 0, pa2); PK4(p1, 8, pa3);
#undef PK4
}
__device__ __forceinline__ void qkt(f32x16& p0, f32x16& p1, const char* Ks, const bf16x8* qr, const char* qp, int r32, int hi) {
    p0 = f32x16{}; p1 = f32x16{};
#pragma unroll
    for (int d0 = 0; d0 < 8; ++d0) { const int cb = (d0 * 16 + hi * 8) * 2;
        const bf16x8 b0 = *reinterpret_cast<const bf16x8*>(Ks + KSWZ(r32, cb));
        const bf16x8 b1 = *reinterpret_cast<const bf16x8*>(Ks + KSWZ(32 + r32, cb));
        const bf16x8 q = d0 < 8 - QPARK ? qr[d0] : *reinterpret_cast<const bf16x8*>(qp + (d0 - (8 - QPARK)) * 8192);
        p0 = __builtin_amdgcn_mfma_f32_32x32x16_bf16(b0, q, p0, 0, 0, 0);
        p1 = __builtin_amdgcn_mfma_f32_32x32x16_bf16(b1, q, p1, 0, 0, 0); }
}
template <int OFF> __device__ __forceinline__ s16x4 trrd(int vb) { s16x4 r; asm volatile("ds_read_b64_tr_b16 %0,%1 offset:%2" : "=&v"(r) : "v"(vb), "n"(OFF) : "memory"); return r; }
template <int BUF, int D0> __device__ __forceinline__ void pv_one(f32x16& o, int vb, bf16x8 pa0, bf16x8 pa1, bf16x8 pa2, bf16x8 pa3) {
    constexpr int B0 = BUF * SHM_V + D0 * 2048;
    const s16x4 lo0 = trrd<B0>(vb), hi0 = trrd<B0 + 128>(vb), lo1 = trrd<B0 + 512>(vb), hi1 = trrd<B0 + 512 + 128>(vb);
    const s16x4 lo2 = trrd<B0 + 8192>(vb), hi2 = trrd<B0 + 8192 + 128>(vb), lo3 = trrd<B0 + 8192 + 512>(vb), hi3 = trrd<B0 + 8192 + 512 + 128>(vb);
    asm volatile("s_waitcnt lgkmcnt(0)" ::: "memory"); SBAR();
#define PK(l, h) (bf16x8){l[0], l[1], l[2], l[3], h[0], h[1], h[2], h[3]}
    o = __builtin_amdgcn_mfma_f32_32x32x16_bf16(pa0, PK(lo0, hi0), o, 0, 0, 0);
    o = __builtin_amdgcn_mfma_f32_32x32x16_bf16(pa1, PK(lo1, hi1), o, 0, 0, 0);
    o = __builtin_amdgcn_mfma_f32_32x32x16_bf16(pa2, PK(lo2, hi2), o, 0, 0, 0);
    o = __builtin_amdgcn_mfma_f32_32x32x16_bf16(pa3, PK(lo3, hi3), o, 0, 0, 0);
#undef PK
}
template <int BUF> __device__ __forceinline__ void pv_d0(f32x16* o, int vb, bf16x8 pa0, bf16x8 pa1, bf16x8 pa2, bf16x8 pa3) {
    pv_one<BUF, 0>(o[0], vb, pa0, pa1, pa2, pa3); pv_one<BUF, 1>(o[1], vb, pa0, pa1, pa2, pa3); pv_one<BUF, 2>(o[2], vb, pa0, pa1, pa2, pa3); pv_one<BUF, 3>(o[3], vb, pa0, pa1, pa2, pa3);
}
__device__ __forceinline__ void attn_head(char* shm, const AttnItem& it, const P2Ctx& C, int kvh, int tid, int wid, int lane) {
    asm volatile("" : "+v"(tid)); lane = tid & 63; wid = __builtin_amdgcn_readfirstlane(tid >> 6);
    const int r32 = lane & 31, hi = lane >> 5;
    char* V_lds = shm; char* K_lds = shm + 2 * SHM_V;
    float* wsx = (float*)(shm + SHM_WS) + wid * 64; float* li_l = wsx; float* al_l = wsx + 32;
    const unsigned long long* Wl = (const unsigned long long*)(shm + ATT_W);
    const int pos = 32 * (wid & 1) + r32, head = kvh * 4 + (wid >> 1);
    const unsigned long long* Wrow = Wl + pos * MW;
    const bf16* qrow = C.Qb + (size_t)(it.m0 + pos) * 1024 + head * 128;
    bf16x8 qr[8]; char* qp = shm + ATT_QP + tid * 16;
    float m_reg = -__builtin_inff(), msub = 0.f, l_reg = 0.f; f32x16 o[4] = {};
    const int sr = tid >> 4, sc = (tid & 15) * 8;
    const int vb0 = (int)(uintptr_t)V_lds + (lane & 15) * 8 + ((lane >> 4) & 1) * 1024 + (lane >> 5) * 256;
    bf16x8 sv0, sv1, sk0, sk1;
    const int TPS = it.ntp;
#define SLOAD(kt) do { const bf16* Kt_ = kv_tile(it, C.Kb, C.CKb, (kt), 256) + kvh * 128 + sc; const bf16* Vt_ = kv_tile(it, C.Vb, C.CVb, (kt), 256) + kvh * 128 + sc; \
    sv0 = ld8(Vt_ + (size_t)sr * 256); sv1 = ld8(Vt_ + (size_t)(32 + sr) * 256); sk0 = ld8(Kt_ + (size_t)sr * 256); sk1 = ld8(Kt_ + (size_t)(32 + sr) * 256); } while (0)
#define SWRITE(buf) do { *(bf16x8*)(V_lds + (buf) * SHM_V + voff(sr, sc)) = sv0; *(bf16x8*)(V_lds + (buf) * SHM_V + voff(32 + sr, sc)) = sv1; const int kc = sc * 2; \
    *(bf16x8*)(K_lds + (buf) * SHM_K + KSWZ(sr, kc)) = sk0; *(bf16x8*)(K_lds + (buf) * SHM_K + KSWZ(32 + sr, kc)) = sk1; } while (0)
#define RESC(a) do { if (__any((a) < 1.f)) { if (hi == 0) al_l[r32] = (a); asm volatile("s_waitcnt lgkmcnt(0)" ::: "memory"); \
    _Pragma("unroll") for (int d = 0; d < 4; ++d) _Pragma("unroll") for (int r = 0; r < 16; ++r) o[d][r] *= al_l[crow(r, hi)]; } } while (0)
    f32x16 pA0, pA1, pB0, pB1; float alA, alB; bf16x8 pa0, pa1, pa2, pa3;
#pragma unroll
    for (int d0 = 0; d0 < 8; ++d0) qr[d0] = ld8(qrow + d0 * 16 + hi * 8);
#pragma unroll
    for (int j = 0; j < QPARK; ++j) *reinterpret_cast<bf16x8*>(qp + j * 8192) = qr[8 - QPARK + j];
    SLOAD(0); SWRITE(0); __syncthreads();
    qkt(pA0, pA1, K_lds, qr, qp, r32, hi); partialSM(pA0, pA1, m_reg, msub, alA, Wrow[0], hi);
    SLOAD(1); SWRITE(1); __syncthreads();
    for (int j = 1; j + 1 < TPS; j += 2) {
        SBAR(); qkt(pB0, pB1, K_lds + SHM_K, qr, qp, r32, hi);
        finishSM(pA0, pA1, alA, l_reg, pa0, pa1, pa2, pa3); SBAR();
        SLOAD(j + 1); SBAR();
        pv_d0<0>(o, vb0, pa0, pa1, pa2, pa3); partialSM(pB0, pB1, m_reg, msub, alB, Wrow[j], hi);
        __syncthreads(); asm volatile("s_waitcnt vmcnt(0)" ::: "memory"); SWRITE(0);
        RESC(alB); __syncthreads();
        SBAR(); qkt(pA0, pA1, K_lds, qr, qp, r32, hi);
        finishSM(pB0, pB1, alB, l_reg, pa0, pa1, pa2, pa3); SBAR();
        if (j + 2 < TPS) { SLOAD(j + 2); SBAR(); }
        pv_d0<1>(o, vb0, pa0, pa1, pa2, pa3); partialSM(pA0, pA1, m_reg, msub, alA, Wrow[j + 1], hi);
        __syncthreads(); if (j + 2 < TPS) { asm volatile("s_waitcnt vmcnt(0)" ::: "memory"); SWRITE(1); }
        RESC(alA); __syncthreads();
    }
    SBAR(); qkt(pB0, pB1, K_lds + SHM_K, qr, qp, r32, hi);
    finishSM(pA0, pA1, alA, l_reg, pa0, pa1, pa2, pa3); SBAR();
    pv_d0<0>(o, vb0, pa0, pa1, pa2, pa3); partialSM(pB0, pB1, m_reg, msub, alB, Wrow[TPS - 1], hi);
    __syncthreads(); RESC(alB);
    finishSM(pB0, pB1, alB, l_reg, pa0, pa1, pa2, pa3); SBAR();
    pv_d0<1>(o, vb0, pa0, pa1, pa2, pa3);
#undef SLOAD
#undef SWRITE
#undef RESC
    if (hi == 0) li_l[r32] = l_reg; asm volatile("s_waitcnt lgkmcnt(0)" ::: "memory");
#pragma unroll
    for (int r = 0; r < 16; ++r) { const float l = li_l[crow(r, hi)]; const float rl = l > 0.f ? __builtin_amdgcn_rcpf(l) : 0.f;
        bf16* yrow = C.Y + (size_t)(it.m0 + 32 * (wid & 1) + crow(r, hi)) * DM + head * 128 + r32;
#pragma unroll
        for (int d0 = 0; d0 < 4; ++d0) { const float g = bf2f(yrow[d0 * 32]); yrow[d0 * 32] = (bf16)(cvt_pk_bf16(o[d0][r] * rl * g, 0.f) & 0xffffu); } }
}
__device__ __forceinline__ void attn_item(char* shm, const AttnItem& it, const P2Ctx& C, int tid, int wid, int lane) {
    LAS unsigned long long* Wl = (LAS unsigned long long*)(shm + ATT_W);
    if (it.nt > 4) {
        if constexpr (P2PARTS & 1) a1_scores(shm, it, C, tid, wid, lane);
        if constexpr (P2PARTS & 2) for (int qi = 0; qi < 8; ++qi) { asm volatile("" : "+v"(lane)); const int q = wid + 8 * qi; const float* srow = C.S + (size_t)q * SLD; LAS unsigned long long* Wq = Wl + q * MW;
            if (it.nt <= 16) a2_select<16>(srow, it.nt, Wq, lane); else if (it.nt <= 32) a2_select<32>(srow, it.nt, Wq, lane); else if (it.nt <= 48) a2_select<48>(srow, it.nt, Wq, lane); else a2_select<65>(srow, it.nt, Wq, lane); }
    } else { for (int i = tid; i < 64 * it.nt; i += NWAVES * 64) Wl[(i / it.nt) * MW + (i % it.nt)] = ~0ull; }
    if (it.ntp > it.nt && tid < 64) Wl[tid * MW + it.nt] = 0ull;
    __syncthreads();
    if constexpr (P2PARTS & 4) { attn_head(shm, it, C, 0, tid, wid, lane); __syncthreads();
    attn_head(shm, it, C, 1, tid, wid, lane); __syncthreads(); }
}

constexpr int DPITCH = 1040;
__device__ __forceinline__ void ld_row8(const bf16* p, float (&v)[8]) { unpack8(*(const GAS v4u*)p, v); }
__device__ __forceinline__ void ld_row8(const float* p, float (&v)[8]) { const f32x4 a = *(const GAS f32x4*)p, b = *(const GAS f32x4*)(p + 4); v[0] = a[0]; v[1] = a[1]; v[2] = a[2]; v[3] = a[3]; v[4] = b[0]; v[5] = b[1]; v[6] = b[2]; v[7] = b[3]; }
__device__ __forceinline__ void cp_item(char* shm, int tile, const P2Ctx& C, int tid, int wid, int lane) {
    asm volatile("" : "+v"(tid)); lane = tid & 63; wid = __builtin_amdgcn_readfirstlane(tid >> 6);
    const int m0 = tile * 64; const bool smp = m0 >= MP; const int b = smp ? (m0 - MP) >> 6 : m0 >> 12, t0 = smp ? 0 : (m0 & (SEQ - 1)), mb = m0 - t0;
    const int c0 = (tid & 63) * 8, r0 = (tid >> 6) * 8;
    {
        float w0[8], w1[8], w2[8], bias[8]; ld_row8(C.conv_w + c0, w0); ld_row8(C.conv_w + 512 + c0, w1); ld_row8(C.conv_w + 1024 + c0, w2); ld_row8(C.conv_b + c0, bias);
        float xm2[8], xm1[8], x0[8];
#define LDX(tt_, v_) do { const int tt__ = (tt_); if (tt__ >= 0) ld_row8(C.CIN + (size_t)(mb + tt__) * 512 + c0, v_); \
            else if (smp) ld_row8(C.state_conv + ((size_t)b * 2 + (2 + tt__)) * 512 + c0, v_); \
            else { _Pragma("unroll") for (int i_ = 0; i_ < 8; ++i_) v_[i_] = 0.f; } } while (0)
        LDX(t0 + r0 - 2, xm2); LDX(t0 + r0 - 1, xm1);
#pragma unroll
        for (int r = 0; r < 8; ++r) {
            const int t = t0 + r0 + r; LDX(t, x0);
            bf16* yp = C.Y + (size_t)(mb + t) * DM + 1024 + c0; float g[8], y[8]; ld_row8(yp, g);
#pragma unroll
            for (int i = 0; i < 8; ++i) { y[i] = g[i] * (xm2[i] * w0[i] + xm1[i] * w1[i] + x0[i] * w2[i] + bias[i]); xm2[i] = xm1[i]; xm1[i] = x0[i]; }
            *(GAS v4u*)yp = pack8(y);
        }
#undef LDX
    }
    {
        const int wl = 2 << (c0 >> 7);
#pragma unroll 1
        for (int r = 0; r < 8; ++r) {
            const int t = t0 + r0 + r; float s[8], pt[8];
#pragma unroll
            for (int i = 0; i < 8; ++i) s[i] = 0.f;
#pragma unroll 1
            for (int j = 0; j < 16; ++j) if (j < wl) {
                const int tt = t - j; float v[8];
                if (tt >= 0) ld_row8(C.PIN + (size_t)(mb + tt) * 512 + c0, v);
                else if (smp) ld_row8(C.state_pool + ((size_t)b * 15 + (15 + tt)) * 512 + c0, v);
                else {
#pragma unroll
                    for (int i = 0; i < 8; ++i) v[i] = 0.f; }
                if (j == 0) {
#pragma unroll
                    for (int i = 0; i < 8; ++i) pt[i] = v[i]; }
#pragma unroll
                for (int i = 0; i < 8; ++i) s[i] += v[i];
            }
            const int cnt = smp ? wl : (t + 1 < wl ? t + 1 : wl); const float rc = 1.0f / (float)cnt;
            float d[8];
#pragma unroll
            for (int i = 0; i < 8; ++i) d[i] = s[i] * rc - pt[i];
            *(v4u*)(shm + (r0 + r) * DPITCH + c0 * 2) = pack8(d);
        }
    }
    __syncthreads();
    {
        const int g = wid >> 1, rh = wid & 1, fr = lane & 15, fq = lane >> 4;
        f32x4 acc[2][8];
#pragma unroll
        for (int mt = 0; mt < 2; ++mt)
#pragma unroll
            for (int nt = 0; nt < 8; ++nt) acc[mt][nt] = (f32x4){0.f, 0.f, 0.f, 0.f};
        bf16x8 af[2][4];
#pragma unroll
        for (int mt = 0; mt < 2; ++mt)
#pragma unroll
            for (int ks = 0; ks < 4; ++ks) af[mt][ks] = *reinterpret_cast<const bf16x8*>(shm + (32 * rh + 16 * mt + fr) * DPITCH + (g * 128 + 32 * ks + 8 * fq) * 2);
#pragma unroll
        for (int nt = 0; nt < 8; ++nt) {
            const bf16* wp = C.PWt + ((size_t)(g * 128 + 16 * nt + fr)) * 128 + 8 * fq;
#pragma unroll
            for (int ks = 0; ks < 4; ++ks) { const bf16x8 bw = ld8(wp + 32 * ks);
#pragma unroll
                for (int mt = 0; mt < 2; ++mt) acc[mt][nt] = __builtin_amdgcn_mfma_f32_16x16x32_bf16(bw, af[mt][ks], acc[mt][nt], 0, 0, 0); }
        }
#pragma unroll
        for (int mt = 0; mt < 2; ++mt)
#pragma unroll
            for (int nt = 0; nt < 8; ++nt) {
                const int row = m0 + 32 * rh + 16 * mt + fr, col = g * 128 + 16 * nt + 4 * fq;
                const f32x4 sc = *(const GAS f32x4*)(C.pool_scale + col); bf16* yp = C.Y + (size_t)row * DM + 1536 + col;
                const v2u gw = *(const GAS v2u*)yp; const f32x4 a = acc[mt][nt];
                v2u o; o.x = cvt_pk_bf16(a[0] * sc[0] * bflo(gw.x), a[1] * sc[1] * bfhi(gw.x)); o.y = cvt_pk_bf16(a[2] * sc[2] * bflo(gw.y), a[3] * sc[3] * bfhi(gw.y));
                *(GAS v2u*)yp = o;
            }
    }
    __syncthreads();
}
__device__ __forceinline__ void p2_phase(const Frame& F, char* shm, const P2Ctx& C, unsigned* qhead) {
    int tid = F.tid; asm volatile("" : "+v"(tid));
    const int lane = tid & 63, wave = __builtin_amdgcn_readfirstlane(tid >> 6);
    for (;;) {
        if (tid == 0) F.MISC[0] = __hip_atomic_fetch_add(qhead, 1u, __ATOMIC_RELAXED, __HIP_MEMORY_SCOPE_AGENT);
        __syncthreads();
        const int item = (int)F.MISC[0];
        __syncthreads();
        if (item >= N_ITEMS) break;
        if (item < N_ATT_ITEMS) {
            AttnItem it;
            if (item < 16) { it.smp = 1; it.b = item; it.m0 = MP + 64 * item; it.nt = 65; }
            else { const int idx = item - 16, c = 63 - (idx >> 3); it.smp = 0; it.b = idx & 7; it.m0 = it.b * SEQ + 64 * c; it.nt = c + 1; }
            it.ntp = (it.nt + 1) & ~1;
            attn_item(shm, it, C, tid, wave, lane);
        } else if constexpr (P2PARTS & 8) cp_item(shm, item - N_ATT_ITEMS, C, tid, wave, lane);
    }
}


#ifndef DIAG_DUMP
#define DIAG_DUMP (-1)
#endif
__device__ __forceinline__ void diag_dump(const Frame& F, float* out, const bf16* a, int lda, const bf16* b, int ldb) {
    int tid = F.tid; asm volatile("" : "+v"(tid)); const int lane = tid & 63, wave = __builtin_amdgcn_readfirstlane(tid >> 6);
    const int gw = F.vcu * NWAVES + wave, NGW = F.G * NWAVES;
    for (int m = gw; m < M; m += NGW)
        for (int h = 0; h < 2; ++h) { const bf16* src = (h ? b : a) + (size_t)m * (h ? ldb : lda); float* dst = out + (size_t)m * DM + h * 1024;
            for (int c = lane * 8; c < 1024; c += 512) { float v[8]; unpack8(*(const GAS v4u*)(src + c), v); st_f32x8(dst + c, v); } }
}
#define DIAG_AT(layer_, stage_, a_, lda_, b_, ldb_) do { if constexpr (DIAG_DUMP >= 0) { if (DIAG_DUMP == 10 * (layer_) + (stage_) && l == (layer_)) { diag_dump(F, XR, a_, lda_, b_, ldb_); return; } } } while (0)
#ifndef PHASES
#define PHASES 0xFF
#endif
__global__ void __launch_bounds__(NWAVES * 64, 2) fwd_kernel(Args A) {
    extern __shared__ __attribute__((aligned(16))) unsigned char lds[];
    Frame F;
    F.lds = (LAS unsigned char*)lds; F.MISC = (volatile LAS unsigned*)(F.lds + MISC_OFF);
    F.tid = threadIdx.x; F.lane = F.tid & 63; F.wave = __builtin_amdgcn_readfirstlane(F.tid >> 6);
    F.G = gridDim.x; { const int bx = blockIdx.x; F.vcu = (F.G % 8 == 0) ? (bx % 8) * (F.G / 8) + bx / 8 : bx; }
    unsigned char* ws = A.ws; F.ctl = (unsigned*)(ws + WS_CTL);
    for (int u = F.tid; u < (LDS_BYTES - LDSCTL_OFF) / 4; u += NWAVES * 64) ((LAS unsigned*)(F.lds + LDSCTL_OFF))[u] = 0u;
    __syncthreads();
    XcdBarrier bar = xcd_barrier_post(F.ctl + CW_BAR, F.MISC + 8);
    float* const XR = A.out + O_Y;
    bf16* const H = (bf16*)(ws + WS_H); bf16* const Y = (bf16*)(ws + WS_Y); bf16* const G = (bf16*)(ws + WS_G); bf16* const Z = H;
#pragma unroll 1
    for (int l = 0; l < 2; ++l) {
        const float* xp = l == 0 ? A.x_prompt : XR; const float* xs = l == 0 ? A.x_sample : XR + (size_t)MP * DM;
        if constexpr (PHASES & 1) p0_prologue(F, A, l, xp, xs);
        xcd_barrier(bar);
        DIAG_AT(0, 0, H, DM, H + 1024, DM); DIAG_AT(1, 0, H, DM, H + 1024, DM); DIAG_AT(0, 8, (const bf16*)(ws + WS_W1B), DM, (const bf16*)(ws + WS_W1B) + 1024, DM);
        if constexpr (PHASES & 2) {
            pg8::Gemm g{H, (const bf16*)(ws + WS_W1A), M, N1A, DM, DM, DM}; pg8::StaticOrder S; S.init(M, N1A, F.G, (int)blockIdx.x);
            EpiP1 E; E.Qb = (bf16*)(ws + WS_Q); E.Kb = (bf16*)(ws + WS_K); E.Vb = (bf16*)(ws + WS_V); E.IQb = (bf16*)(ws + WS_IQ); E.IKb = (bf16*)(ws + WS_IK); E.Y = Y; E.CIN = (bf16*)(ws + WS_CIN); E.PIN = (bf16*)(ws + WS_PIN); E.IW = (float*)(ws + WS_IW);
            E.k_p = A.out + O_KP + (size_t)l * MP * 256; E.k_s = A.out + O_KS + (size_t)l * MS * 256; E.v_p = A.out + O_VP + (size_t)l * MP * 256; E.v_s = A.out + O_VS + (size_t)l * MS * 256;
            E.ik_p = A.out + O_IKP + (size_t)l * MP * 64; E.ik_s = A.out + O_IKS + (size_t)l * MS * 64; E.cv_p = A.out + O_CP + (size_t)l * 8 * 2 * 512; E.cv_s = A.out + O_CS + (size_t)l * 16 * 2 * 512;
            E.pl_p = A.out + O_PP + (size_t)l * 8 * 15 * 512; E.pl_s = A.out + O_PS + (size_t)l * 16 * 15 * 512;
            pg8::gemm_phase<EpiP1, pg8::StaticOrder, true, true>(F.lds, g, S, E);
        }
        xcd_barrier(bar);
        DIAG_AT(0, 1, Y, DM, Y + 1024, DM); DIAG_AT(1, 1, Y, DM, Y + 1024, DM); DIAG_AT(0, 6, (const bf16*)(ws + WS_Q), 1024, (const bf16*)(ws + WS_IQ), 1024); DIAG_AT(0, 7, (const bf16*)(ws + WS_CIN), 512, (const bf16*)(ws + WS_PIN), 512);
        if constexpr (PHASES & 4) {
            P2Ctx C; C.Qb = (const bf16*)(ws + WS_Q); C.Kb = (const bf16*)(ws + WS_K); C.Vb = (const bf16*)(ws + WS_V); C.IQb = (const bf16*)(ws + WS_IQ); C.IKb = (const bf16*)(ws + WS_IK);
            C.CKb = (const bf16*)(ws + WS_CK); C.CVb = (const bf16*)(ws + WS_CV); C.CIKb = (const bf16*)(ws + WS_CIK); C.CIN = (const bf16*)(ws + WS_CIN); C.PIN = (const bf16*)(ws + WS_PIN); C.PWt = (const bf16*)(ws + WS_PW);
            C.IW = (const float*)(ws + WS_IW); C.Y = Y;
            C.state_conv = A.state_conv + (size_t)l * 16 * 2 * 512; C.state_pool = A.state_pool + (size_t)l * 16 * 15 * 512; C.conv_w = A.conv_w + (size_t)l * 3 * 512; C.conv_b = A.conv_b + (size_t)l * 512; C.pool_scale = A.pool_scale + (size_t)l * 512;
            C.S = (float*)(ws + WS_S + (size_t)blockIdx.x * S_WG_BYTES);
            p2_phase(F, (char*)lds, C, F.ctl + CW_QUEUE + 64 * l);
        }
        xcd_barrier(bar);
        DIAG_AT(0, 2, Y, DM, Y + 1024, DM); DIAG_AT(1, 2, Y, DM, Y + 1024, DM);
        if constexpr (PHASES & 8) {
            pg8::Gemm g{H, (const bf16*)(ws + WS_W1B), M, N1B, DM, DM, DM}; pg8::StaticOrder S; S.init(M, N1B, F.G, (int)blockIdx.x);
            EpiP3 E; E.G = G;
            pg8::gemm_phase<EpiP3, pg8::StaticOrder, true, true>(F.lds, g, S, E);
        }
        xcd_barrier(bar);
        DIAG_AT(0, 3, G, N1B, G + 1024, N1B); DIAG_AT(1, 3, G, N1B, G + 1024, N1B);
        if constexpr (PHASES & 16) {
            pg8::Gemm g{Y, (const bf16*)(ws + WS_WL), M, DM, 512, DM, DM}; pg8::SegOrder<4, 512> S; S.init(M, DM, F.G, (int)blockIdx.x);
            EpiP4 E; E.G = G; E.Z = Z;
            pg8::gemm_phase<EpiP4, pg8::SegOrder<4, 512>, true, true>(F.lds, g, S, E);
        }
        xcd_barrier(bar);
        DIAG_AT(0, 4, Z, DM, Z + 1024, DM); DIAG_AT(1, 4, Z, DM, Z + 1024, DM);
        if constexpr (PHASES & 32) {
            pg8::Gemm g{Z, (const bf16*)(ws + WS_WO), M, DM, DM, DM, DM}; pg8::StaticOrder S; S.init(M, DM, F.G, (int)blockIdx.x);
            EpiP5 E; E.xp = xp; E.xs = xs; E.out = XR;
            pg8::gemm_phase<EpiP5, pg8::StaticOrder, true, true>(F.lds, g, S, E);
        }
        xcd_barrier(bar);
        if constexpr (DIAG_DUMP >= 0) { if (DIAG_DUMP == 10 * l + 5) return; }
    }
    { int tid = F.tid; asm volatile("" : "+v"(tid)); const int lane = tid & 63, wave = __builtin_amdgcn_readfirstlane(tid >> 6);
      const int gw = F.vcu * NWAVES + wave, NGW = F.G * NWAVES;
      for (int m = gw; m < M; m += NGW) rmsnorm_row<false>(XR + (size_t)m * DM, A.final_g, XR + (size_t)m * DM, lane); }
}

extern "C" void kernel_launch(void* const* d_in, const int* in_sizes, int n_in, void* d_out, int out_size, void* d_ws, size_t ws_size, hipStream_t stream) {
    static int grid = 0;
    if (grid == 0) {
        if (n_in != 18 || in_sizes[0] != MP * DM || ws_size < WS_END) { fprintf(stderr, "kernel_launch: unexpected shapes (n_in %d, in0 %d, out %d, ws %zu; need ws >= %zu); nothing launched\n", n_in, n_in > 0 ? in_sizes[0] : -1, out_size, ws_size, (size_t)WS_END); grid = -1; return; }
        int dev = 0, cus = 0, per_cu = 0;
        if (hipGetDevice(&dev) != hipSuccess || hipDeviceGetAttribute(&cus, hipDeviceAttributeMultiprocessorCount, dev) != hipSuccess) { fprintf(stderr, "kernel_launch: device query failed\n"); grid = -1; return; }
        if (hipFuncSetAttribute((const void*)fwd_kernel, hipFuncAttributeMaxDynamicSharedMemorySize, LDS_BYTES) != hipSuccess) { fprintf(stderr, "kernel_launch: hipFuncSetAttribute failed\n"); grid = -1; return; }
        if (hipOccupancyMaxActiveBlocksPerMultiprocessor(&per_cu, (const void*)fwd_kernel, NWAVES * 64, LDS_BYTES) != hipSuccess || per_cu < 1) { fprintf(stderr, "kernel_launch: occupancy query reports %d workgroups per CU\n", per_cu); }
        (void)hipGetLastError();
        grid = cus > 256 ? 256 : cus;
    }
    if (grid < 0) return;
    if (hipMemsetAsync((char*)d_ws + WS_CTL, 0, CTL_ZERO_BYTES, stream) != hipSuccess) { fprintf(stderr, "kernel_launch: memset failed\n"); return; }
    if (DIAG_DUMP >= 0) (void)hipMemsetAsync(d_out, 0, (size_t)out_size * 4, stream);
    Args a{};
    a.x_prompt = (const float*)d_in[0]; a.x_sample = (const float*)d_in[1]; a.cache_k = (const float*)d_in[2]; a.cache_v = (const float*)d_in[3]; a.cache_ik = (const float*)d_in[4];
    a.state_conv = (const float*)d_in[5]; a.state_pool = (const float*)d_in[6]; a.norm_g = (const float*)d_in[7]; a.w_in = (const float*)d_in[8]; a.conv_w = (const float*)d_in[9]; a.conv_b = (const float*)d_in[10];
    a.pool_w = (const float*)d_in[11]; a.pool_scale = (const float*)d_in[12]; a.lift_a = (const float*)d_in[13]; a.lift_b = (const float*)d_in[14]; a.lift_c = (const float*)d_in[15]; a.w_out = (const float*)d_in[16]; a.final_g = (const float*)d_in[17];
    a.out = (float*)d_out; a.ws = (unsigned char*)d_ws;
    hipLaunchKernelGGL(fwd_kernel, dim3(grid), dim3(NWAVES * 64), LDS_BYTES, stream, a);
    const hipError_t le = hipPeekAtLastError();
    if (le != hipSuccess) fprintf(stderr, "kernel_launch: launch failed: %s\n", hipGetErrorName(le));
}
```

```cpp
#include <hip/hip_runtime.h>
#include <cstdio>
#include <cstdint>

namespace pg8 {
#define PG8_LAS __attribute__((address_space(3)))
typedef unsigned short bf16_t;
typedef short bf16x8 __attribute__((ext_vector_type(8)));
typedef float f32x4 __attribute__((ext_vector_type(4)));
typedef unsigned u32x4 __attribute__((ext_vector_type(4)));
constexpr int BM = 256, BK = 64, HALF = 128, HTB = HALF * BK * 2  , STAGE_BYTES = 8 * HTB, NXCD = 8, WGM = 8;

__host__ __device__ __forceinline__ int lds_byte(int r, int c) { const int st = (r >> 4) * 2 + (c >> 5), rr = r & 15, cc = c & 31, ob = rr * 64 + cc * 2; return st * 1024 + (ob ^ (((ob >> 9) & 1) << 5)); }
__host__ __device__ __forceinline__ void stage_rc(int b, int& R, int& C) { const int st = b / 1024, sb = b % 1024, swz = sb ^ (((sb >> 9) & 1) << 5); R = (st >> 1) * 16 + swz / 64; C = (st & 1) * 32 + (swz % 64) / 2; }
__host__ __device__ __forceinline__ int perm32(int rho) { const int n = rho >> 4, i = rho & 15; return 8 * (i >> 2) + 4 * n + (i & 3); }

struct Unit { int pm, pn, koff, seg; };
struct Gemm { const bf16_t* A; const bf16_t* Bt; int M, N, K, lda, ldb; };

struct StaticOrder {
    int nM, nN, nwg, G, c;
    __host__ __device__ void init(int M, int N, int G_, int c_) { nM = M / BM; nN = N / BM; nwg = nM * nN; G = G_; c = c_; }
    __host__ __device__ bool next(int i, Unit& u) const {
        const long L = (long)i * G + c; if (L >= nwg) return false;
        int wgid = (int)L; { const int q = nwg / NXCD, r = nwg % NXCD, xcd = wgid % NXCD, off = wgid / NXCD; wgid = (xcd < r ? xcd * (q + 1) : r * (q + 1) + (xcd - r) * q) + off; }
        const int nig = WGM * nN, gid = wgid / nig, fm = gid * WGM, gsz = (nM - fm) < WGM ? (nM - fm) : WGM;
        u.pm = fm + ((wgid % nig) % gsz); u.pn = (wgid % nig) / gsz; u.koff = 0; u.seg = 0; return true;
    }
    __device__ __forceinline__ void a_ready(const Unit&) const {}
    __device__ __forceinline__ void done(const Unit&) const {}
};
template <int NSEG, int KS> struct SegOrder : StaticOrder {
    __host__ __device__ bool next(int i, Unit& u) const { if (!StaticOrder::next(i / NSEG, u)) return false; u.seg = i % NSEG; u.koff = u.seg * KS; return true; }
};
typedef int i32x8 __attribute__((ext_vector_type(8)));
typedef int i32x4 __attribute__((ext_vector_type(4)));
__device__ __forceinline__ i32x8 cat8(bf16x8 a, bf16x8 b) { const i32x4 x = __builtin_bit_cast(i32x4, a), y = __builtin_bit_cast(i32x4, b); return __builtin_shufflevector(x, y, 0, 1, 2, 3, 4, 5, 6, 7); }
__device__ __forceinline__ unsigned cvt_pk_bf16(float lo, float hi) { typedef float f2_ __attribute__((ext_vector_type(2))); typedef __bf16 b2_ __attribute__((ext_vector_type(2))); const b2_ r = __builtin_convertvector((f2_){lo, hi}, b2_); return __builtin_bit_cast(unsigned, r); }

template <class Epi, class Sched, bool ALIGN_EPI = false, bool SP2 = false>
__device__ __forceinline__ void gemm_phase(PG8_LAS unsigned char* lds, const Gemm g, const Sched& S, const Epi& E) {
    int tid_ = threadIdx.x; asm volatile("" : "+v"(tid_));
    const int tid = tid_, wid = __builtin_amdgcn_readfirstlane(tid >> 6), lane = tid & 63, wr = wid >> 2, wc = wid & 3, fr = lane & 15, fq = lane >> 4;
    const int K = g.K, nt = K / BK;
    unsigned voffA[2], voffB[2];
#pragma unroll
    for (int i = 0; i < 2; ++i) { int R, C; stage_rc(tid * 16 + i * 8192, R, C); const int Rb = Epi::PERM ? ((R & ~31) + perm32(R & 31)) : R;
        voffA[i] = (unsigned)(R * g.lda + C) * 2u; voffB[i] = (unsigned)(Rb * g.ldb + C) * 2u; }
    const size_t kstep = (size_t)(BK * 2);
    const size_t hstepA = (size_t)HALF * g.lda * 2, hstepB = (size_t)HALF * g.ldb * 2;
    const size_t tstepA = 2 * hstepA, tstepB = 2 * hstepB;
    const unsigned ldsw = (unsigned)wid * 1024u;
    const int aoff = lds_byte(wr * 64 + fr, fq * 8), boff = lds_byte(wc * 32 + fr, fq * 8);
#define PG8_SA(b, h) (((b) * 2 + (h)) * HTB)
#define PG8_SB(b, h) ((4 + (b) * 2 + (h)) * HTB)
#define PG8_STAGE(bufoff, gbase, voff) do { _Pragma("unroll") for (int _i = 0; _i < 2; ++_i) \
        __builtin_amdgcn_global_load_lds((const unsigned*)((const char*)(gbase) + (voff)[_i]), (PG8_LAS unsigned*)(lds + (bufoff) + ldsw + _i * 8192), 16, 0, 0); } while (0)
#define PG8_RD(off_) (*(const PG8_LAS i32x4*)(lds + (off_)))
#define PG8_LDA(dst, b, h) do { _Pragma("unroll") for (int m = 0; m < 4; ++m) dst[m] = __builtin_shufflevector(PG8_RD(PG8_SA(b, h) + aoff + m * 2048), PG8_RD(PG8_SA(b, h) + aoff + m * 2048 + 1024), 0, 1, 2, 3, 4, 5, 6, 7); } while (0)
#define PG8_LDB(dst, b, h) do { _Pragma("unroll") for (int n = 0; n < 2; ++n) dst[n] = __builtin_shufflevector(PG8_RD(PG8_SB(b, h) + boff + n * 2048), PG8_RD(PG8_SB(b, h) + boff + n * 2048 + 1024), 0, 1, 2, 3, 4, 5, 6, 7); } while (0)
#define PG8_LO(v_) __builtin_bit_cast(bf16x8, __builtin_shufflevector(v_, v_, 0, 1, 2, 3))
#define PG8_HI(v_) __builtin_bit_cast(bf16x8, __builtin_shufflevector(v_, v_, 4, 5, 6, 7))
#define PG8_MMA(ai, bj, At, Bt) do { __builtin_amdgcn_s_setprio(1); if constexpr (Epi::FP8) { \
          \
        _Pragma("unroll") for (int m = 0; m < 4; ++m) _Pragma("unroll") for (int n = 0; n < 2; ++n) \
        asm volatile("v_mfma_scale_f32_16x16x128_f8f6f4 %0, %1, %2, %0, %3, %3 op_sel_hi:[0,0,0]" : "+v"(acc[ai][bj][m][n]) : "v"(Bt[n]), "v"(At[m]), "v"(mx_one));   \
    } else { _Pragma("unroll") for (int m = 0; m < 4; ++m) _Pragma("unroll") for (int n = 0; n < 2; ++n) { \
        acc[ai][bj][m][n] = __builtin_amdgcn_mfma_f32_16x16x32_bf16(PG8_LO(Bt[n]), PG8_LO(At[m]), acc[ai][bj][m][n], 0, 0, 0); \
        acc[ai][bj][m][n] = __builtin_amdgcn_mfma_f32_16x16x32_bf16(PG8_HI(Bt[n]), PG8_HI(At[m]), acc[ai][bj][m][n], 0, 0, 0); } } __builtin_amdgcn_s_setprio(0); } while (0)
#define PG8_WAIT_V(n) asm volatile("s_waitcnt vmcnt(" #n ")" ::: "memory")
#define PG8_WAIT_L(n) asm volatile("s_waitcnt lgkmcnt(" #n ")" ::: "memory")
#define PG8_BAR __builtin_amdgcn_s_barrier()
#define PG8_SCHED __builtin_amdgcn_sched_barrier(0)
    Unit cur, nxt; int ui = 0;
    if (!S.next(0, cur)) return;
    f32x4 acc[2][2][4][2];
#pragma unroll
    for (int a = 0; a < 2; ++a)
#pragma unroll
        for (int b = 0; b < 2; ++b)
#pragma unroll
            for (int m = 0; m < 4; ++m)
#pragma unroll
                for (int n = 0; n < 2; ++n) acc[a][b][m][n] = (f32x4){0.f, 0.f, 0.f, 0.f};
    i32x8 At[4], B0[2], B1[2];
    int mx_one = 0x7f7f7f7f; asm volatile("" : "+v"(mx_one));
    const char* cA = (const char*)g.A + (size_t)cur.pm * tstepA + (size_t)cur.koff * 2; const char* cB = (const char*)g.Bt + (size_t)cur.pn * tstepB + (size_t)cur.koff * 2;
    S.a_ready(cur);
    if constexpr (SP2) {
        PG8_STAGE(PG8_SB(0, 0), cB, voffB); PG8_STAGE(PG8_SB(0, 1), cB + hstepB, voffB); PG8_STAGE(PG8_SA(0, 0), cA, voffA); PG8_STAGE(PG8_SA(0, 1), cA + hstepA, voffA);
        if (wr == 1) PG8_BAR;
        PG8_WAIT_V(2); PG8_BAR;
        PG8_STAGE(PG8_SB(1, 0), cB + kstep, voffB); PG8_STAGE(PG8_SA(1, 0), cA + kstep, voffA); PG8_STAGE(PG8_SB(1, 1), cB + hstepB + kstep, voffB);
        PG8_WAIT_V(6); PG8_BAR;
    } else {
        PG8_STAGE(PG8_SB(0, 0), cB, voffB); PG8_STAGE(PG8_SA(0, 0), cA, voffA); PG8_STAGE(PG8_SB(0, 1), cB + hstepB, voffB); PG8_STAGE(PG8_SA(0, 1), cA + hstepA, voffA);
        if (wr == 1) PG8_BAR;
        PG8_WAIT_V(4); PG8_BAR;
        PG8_STAGE(PG8_SB(1, 0), cB + kstep, voffB); PG8_STAGE(PG8_SA(1, 0), cA + kstep, voffA); PG8_STAGE(PG8_SB(1, 1), cB + hstepB + kstep, voffB);
        PG8_WAIT_V(6); PG8_BAR;
    }
    for (;;) {
        const bool has_next = S.next(ui + 1, nxt);
        const char* nA = has_next ? (const char*)g.A + (size_t)nxt.pm * tstepA + (size_t)nxt.koff * 2 : cA; const char* nB = has_next ? (const char*)g.Bt + (size_t)nxt.pn * tstepB + (size_t)nxt.koff * 2 : cB;
        for (int t = 0; t < nt; t += 2) {
            const bool last = (t == nt - 2);
            const char* a1 = cA + (size_t)(t + 1) * kstep;
            const char* a2 = last ? nA : cA + (size_t)(t + 2) * kstep; const char* b2 = last ? nB : cB + (size_t)(t + 2) * kstep;
            const char* a3 = a2 + kstep; const char* b3 = b2 + kstep;
            if (last && has_next) S.a_ready(nxt);
            if constexpr (SP2) {
            PG8_LDB(B0, 0, 0); PG8_LDB(B1, 0, 1); PG8_SCHED; PG8_LDA(At, 0, 0); PG8_STAGE(PG8_SA(1, 1), a1 + hstepA, voffA);
            PG8_WAIT_V(8); PG8_WAIT_L(0); PG8_BAR; PG8_MMA(0, 0, At, B0); PG8_MMA(0, 1, At, B1); PG8_BAR; PG8_SCHED;
            PG8_LDA(At, 0, 1); PG8_STAGE(PG8_SB(0, 0), b2, voffB); PG8_STAGE(PG8_SB(0, 1), b2 + hstepB, voffB); PG8_STAGE(PG8_SA(0, 0), a2, voffA);
            PG8_WAIT_V(8); PG8_WAIT_L(0); PG8_BAR; PG8_MMA(1, 0, At, B0); PG8_MMA(1, 1, At, B1); PG8_BAR; PG8_SCHED;
            PG8_LDB(B0, 1, 0); PG8_LDB(B1, 1, 1); PG8_SCHED; PG8_LDA(At, 1, 0); PG8_STAGE(PG8_SA(0, 1), a2 + hstepA, voffA);
            PG8_WAIT_V(8); PG8_WAIT_L(0); PG8_BAR; PG8_MMA(0, 0, At, B0); PG8_MMA(0, 1, At, B1); PG8_BAR; PG8_SCHED;
            PG8_LDA(At, 1, 1); PG8_STAGE(PG8_SB(1, 0), b3, voffB); PG8_STAGE(PG8_SB(1, 1), b3 + hstepB, voffB); PG8_STAGE(PG8_SA(1, 0), a3, voffA);
            PG8_WAIT_V(8); PG8_WAIT_L(0); PG8_BAR; PG8_MMA(1, 0, At, B0); PG8_MMA(1, 1, At, B1); PG8_BAR; PG8_SCHED;
            } else {
            PG8_LDB(B0, 0, 0); PG8_SCHED; PG8_LDA(At, 0, 0); PG8_STAGE(PG8_SA(1, 1), a1 + hstepA, voffA);
            PG8_WAIT_L(8); PG8_BAR; PG8_WAIT_L(0); PG8_MMA(0, 0, At, B0); PG8_BAR; PG8_SCHED;
            PG8_LDB(B1, 0, 1); PG8_STAGE(PG8_SB(0, 0), b2, voffB);
            PG8_BAR; PG8_WAIT_L(0); PG8_MMA(0, 1, At, B1); PG8_BAR;
            PG8_LDA(At, 0, 1); PG8_STAGE(PG8_SA(0, 0), a2, voffA);
            PG8_BAR; PG8_WAIT_L(0); PG8_MMA(1, 0, At, B0); PG8_BAR; PG8_SCHED;
            PG8_STAGE(PG8_SB(0, 1), b2 + hstepB, voffB);
            PG8_WAIT_V(6); PG8_BAR; PG8_MMA(1, 1, At, B1); PG8_BAR;
            PG8_LDB(B0, 1, 0); PG8_SCHED; PG8_LDA(At, 1, 0); PG8_STAGE(PG8_SA(0, 1), a2 + hstepA, voffA);
            PG8_WAIT_L(8); PG8_BAR; PG8_WAIT_L(0); PG8_MMA(0, 0, At, B0); PG8_BAR; PG8_SCHED;
            PG8_LDB(B1, 1, 1); PG8_STAGE(PG8_SB(1, 0), b3, voffB);
            PG8_BAR; PG8_WAIT_L(0); PG8_MMA(0, 1, At, B1); PG8_BAR;
            PG8_LDA(At, 1, 1); PG8_STAGE(PG8_SA(1, 0), a3, voffA);
            PG8_BAR; PG8_WAIT_L(0); PG8_MMA(1, 0, At, B0); PG8_BAR; PG8_SCHED;
            PG8_STAGE(PG8_SB(1, 1), b3 + hstepB, voffB);
            PG8_WAIT_V(6); PG8_BAR; PG8_MMA(1, 1, At, B1); PG8_BAR;
            }
        }
        if constexpr (ALIGN_EPI) { if (wr == 0) PG8_BAR; }
        if constexpr (Epi::FP8) asm volatile("s_nop 15\n\ts_nop 15" ::: "memory");
        if constexpr (!Epi::AFTER_DRAIN) { E(acc, cur, wr, wc, fr, fq); S.done(cur); }
        if (!has_next) break;
        if (cur.seg == Epi::NSEG - 1)
#pragma unroll
        for (int a = 0; a < 2; ++a)
#pragma unroll
            for (int b = 0; b < 2; ++b)
#pragma unroll
                for (int m = 0; m < 4; ++m)
#pragma unroll
                    for (int n = 0; n < 2; ++n) acc[a][b][m][n] = (f32x4){0.f, 0.f, 0.f, 0.f};
        cur = nxt; cA = nA; cB = nB; ++ui;
        if constexpr (ALIGN_EPI) { if (wr == 1) PG8_BAR; }
    }
    PG8_WAIT_V(0);
    if constexpr (!ALIGN_EPI) { if (wr == 0) PG8_BAR; }
    PG8_BAR;
    if constexpr (Epi::AFTER_DRAIN) { E.fused(acc, cur, wr, wc, fr, fq, lds, wid, lane); S.done(cur); }
#undef PG8_SA
#undef PG8_SB
#undef PG8_STAGE
#undef PG8_LDA
#undef PG8_RD
#undef PG8_LO
#undef PG8_HI
#undef PG8_LDB
#undef PG8_MMA
#undef PG8_WAIT_V
#undef PG8_WAIT_L
#undef PG8_BAR
#undef PG8_SCHED
}

}

constexpr int NWAVES = 8;
constexpr int DM = 2048, MP = 32768, MS = 1024, M = MP + MS;
constexpr int SEQ = 4096, PAST = 4096, DSEQ = 64, NB_P = 8, NB_S = 16;
constexpr int IN_W = 12880;
constexpr int N1A = 6912, N1B = 6144;
constexpr int C_Q = 0, C_K = 1024, C_V = 1280, C_IQ = 1536, C_IK = 2560, C_IW = 2624, C_GA = 2640, C_U = 3664, C_BGT = 4176, C_CG = 4688, C_GB = 5200, C_PIN = 5712, C_GC = 6224, C_MA = 6736;
constexpr float EPS = 1e-6f;
constexpr int SLD = 4224;
constexpr int MW = 66;
constexpr int N_ATT_ITEMS = 16 + 512, N_CP_ITEMS = M / 64, N_ITEMS = N_ATT_ITEMS + N_CP_ITEMS;

constexpr size_t MiB = 1u << 20;
constexpr size_t al256(size_t x) { return (x + 255) / 256 * 256; }
constexpr size_t WS_CTL = 0, CTL_ZERO_BYTES = 1 * MiB;
constexpr size_t WS_W1A = 1 * MiB;
constexpr size_t WS_W1B = WS_W1A + (size_t)N1A * DM * 2;
constexpr size_t WS_WL = WS_W1B + (size_t)N1B * DM * 2;
constexpr size_t WS_WO = WS_WL + (size_t)DM * DM * 2;
constexpr size_t WS_PW = WS_WO + (size_t)DM * DM * 2;
constexpr size_t WS_H = al256(WS_PW + 4 * 128 * 128 * 2);
constexpr size_t WS_Y = WS_H + (size_t)M * DM * 2;
constexpr size_t WS_Q = WS_Y + (size_t)M * DM * 2;
constexpr size_t WS_K = WS_Q + (size_t)M * 1024 * 2;
constexpr size_t WS_V = WS_K + (size_t)M * 256 * 2;
constexpr size_t WS_IQ = WS_V + (size_t)M * 256 * 2;
constexpr size_t WS_IK = WS_IQ + (size_t)M * 1024 * 2;
constexpr size_t WS_IW = WS_IK + (size_t)M * 64 * 2;
constexpr size_t WS_CIN = WS_IW + (size_t)M * 16 * 4;
constexpr size_t WS_PIN = WS_CIN + (size_t)M * 512 * 2;
constexpr size_t WS_CK = WS_PIN + (size_t)M * 512 * 2;
constexpr size_t WS_CV = WS_CK + (size_t)NB_S * PAST * 256 * 2;
constexpr size_t WS_CIK = WS_CV + (size_t)NB_S * PAST * 256 * 2;
constexpr size_t WS_G = WS_CIK + (size_t)NB_S * PAST * 64 * 2;
constexpr size_t WS_H8 = WS_G + (size_t)M * N1B;
constexpr size_t WS_W8 = WS_H8 + (size_t)M * DM;
constexpr size_t WS_END = WS_W8 + (size_t)N1B * DM;
constexpr size_t WS_S = WS_H;
constexpr size_t S_WG_BYTES = (size_t)64 * SLD * 2;
static_assert(256 * S_WG_BYTES <= (size_t)M * DM * 2, "score scratch fits the H region");
static_assert(WS_END <= (size_t)1024 * MiB, "workspace map must fit 1 GiB");
constexpr int CW_BAR = 4096;
constexpr int CW_QUEUE = 8192;

constexpr int RING_BYTES = 131072;
constexpr int LDS_BYTES = 155648;
constexpr int LDSCTL_OFF = LDS_BYTES - 1024, MISC_OFF = LDSCTL_OFF + 320;

#define GAS __attribute__((address_space(1)))
#define LAS __attribute__((address_space(3)))
typedef unsigned short bf16;
typedef unsigned v4u __attribute__((ext_vector_type(4)));
typedef unsigned v2u __attribute__((ext_vector_type(2)));
typedef float f32x4 __attribute__((ext_vector_type(4)));
typedef float f32x16 __attribute__((ext_vector_type(16)));
typedef short bf16x8 __attribute__((ext_vector_type(8)));
typedef short s16x4 __attribute__((ext_vector_type(4)));
#define LDS_WAIT() asm volatile("s_waitcnt lgkmcnt(0)" ::: "memory")
#define VM_WAIT() asm volatile("s_waitcnt vmcnt(0)" ::: "memory")
using pg8::cvt_pk_bf16;
__device__ __forceinline__ float bf2f(unsigned short b) { return __builtin_bit_cast(float, (unsigned)b << 16); }
__device__ __forceinline__ float bflo(unsigned w) { return __builtin_bit_cast(float, w << 16); }
__device__ __forceinline__ float bfhi(unsigned w) { return __builtin_bit_cast(float, w & 0xffff0000u); }
__device__ __forceinline__ v4u pack8(const float (&v)[8]) { v4u w; w.x = cvt_pk_bf16(v[0], v[1]); w.y = cvt_pk_bf16(v[2], v[3]); w.z = cvt_pk_bf16(v[4], v[5]); w.w = cvt_pk_bf16(v[6], v[7]); return w; }
__device__ __forceinline__ void unpack8(v4u w, float (&v)[8]) { v[0] = bflo(w.x); v[1] = bfhi(w.x); v[2] = bflo(w.y); v[3] = bfhi(w.y); v[4] = bflo(w.z); v[5] = bfhi(w.z); v[6] = bflo(w.w); v[7] = bfhi(w.w); }
__device__ __forceinline__ float sigmoidf_(float x) { return __builtin_amdgcn_rcpf(1.0f + __builtin_amdgcn_exp2f(-1.4426950408889634f * x)); }
__device__ __forceinline__ float siluf_(float x) { return x * sigmoidf_(x); }
#define dpp_f(v_, ctrl_) __builtin_bit_cast(float, __builtin_amdgcn_update_dpp(0, __builtin_bit_cast(int, (v_)), (ctrl_), 0xF, 0xF, true))
__device__ __forceinline__ float wave_sum(float v) {
    v += dpp_f(v, 0xB1); v += dpp_f(v, 0x4E); v += dpp_f(v, 0x141); v += dpp_f(v, 0x140);
    const int vi = __builtin_bit_cast(int, v);
    return (__builtin_bit_cast(float, __builtin_amdgcn_readlane(vi, 0)) + __builtin_bit_cast(float, __builtin_amdgcn_readlane(vi, 16))) + (__builtin_bit_cast(float, __builtin_amdgcn_readlane(vi, 32)) + __builtin_bit_cast(float, __builtin_amdgcn_readlane(vi, 48)));
}

#define XB_TMO      128
#define XB_XCNT(j)  (256  + 64 * (j))
#define XB_XSUB(j)  (1280 + 64 * (j))
#define XB_XGEN(j)  (2304 + 64 * (j))
#define XB_TOP      3328
#define XB_TOPGEN   3392
#define XCD_BAR_WORDS 3456
#define XB_SPIN_CAP (1u << 18)

__device__ __forceinline__ unsigned xb_ld(unsigned* p)              { return __hip_atomic_load(p, __ATOMIC_RELAXED, __HIP_MEMORY_SCOPE_AGENT); }
__device__ __forceinline__ unsigned xb_add(unsigned* p, unsigned v) { return __hip_atomic_fetch_add(p, v, __ATOMIC_RELAXED, __HIP_MEMORY_SCOPE_AGENT); }
__device__ __forceinline__ unsigned xb_xcc_id() { return (unsigned)__builtin_amdgcn_s_getreg((3 << 11) | 20) & 0xFu; }
#define XB_SPIN(cond, bar) do { unsigned _sp = 0; while (cond) { __builtin_amdgcn_s_sleep(1); \
    if ((++_sp & 255u) == 0u) { if (xb_ld(&(bar)[XB_TMO])) break; if (_sp > XB_SPIN_CAP) { atomicAdd(&(bar)[XB_TMO], 1u); break; } } } } while (0)

struct XcdBarrier {
    unsigned* bar; unsigned x;
    volatile LAS unsigned* st;
};

__device__ __forceinline__ XcdBarrier xcd_barrier_post(unsigned* bar, volatile LAS unsigned* st) {
    XcdBarrier b; b.bar = bar; b.x = xb_xcc_id(); b.st = st;
    if (threadIdx.x == 0) (void)xb_add(&bar[XB_XCNT(b.x)], 1u);
    return b;
}
__device__ __forceinline__ void xcd_barrier_complete(unsigned* bar, unsigned x, unsigned& nloc, unsigned& nx) {
    const unsigned G = gridDim.x * gridDim.y * gridDim.z;
    unsigned sum, cnt, mine, sp = 0u;
    for (;;) {
        sum = 0u; cnt = 0u; mine = 0u;
#pragma unroll
        for (unsigned j = 0; j < 16; ++j) { const unsigned c = xb_ld(&bar[XB_XCNT(j)]); sum += c; cnt += (c > 0u) ? 1u : 0u; mine = (j == x) ? c : mine; }
        if (sum == G) break;
        __builtin_amdgcn_s_sleep(1);
        if ((++sp & 255u) == 0u) { if (xb_ld(&bar[XB_TMO])) break; if (sp > XB_SPIN_CAP) { atomicAdd(&bar[XB_TMO], 1u); break; } }
    }
    nloc = mine > 0u ? mine : 1u; nx = cnt > 0u ? cnt : 1u;
}

__device__ __forceinline__ void xcd_barrier(const XcdBarrier& b) {
    asm volatile("s_waitcnt vmcnt(0)" ::: "memory");
    __syncthreads();
    if (threadIdx.x == 0) {
        unsigned* bar = b.bar;
        __builtin_amdgcn_s_waitcnt(0);
        unsigned nloc = b.st[0], nx = b.st[1];
        if (nloc == 0u) { xcd_barrier_complete(bar, b.x, nloc, nx); b.st[0] = nloc; b.st[1] = nx; }
        const unsigned old = xb_add(&bar[XB_XSUB(b.x)], 1u);
        const unsigned gen = old / nloc;
        if (old + 1u == (gen + 1u) * nloc) {
            __builtin_amdgcn_fence(__ATOMIC_RELEASE, "agent");
            asm volatile("s_waitcnt vmcnt(0)" ::: "memory");
            const unsigned og = xb_add(&bar[XB_TOP], 1u);
            const unsigned tg = og / nx;
            if (og + 1u == (tg + 1u) * nx) xb_add(&bar[XB_TOPGEN], 1u);
            else XB_SPIN(xb_ld(&bar[XB_TOPGEN]) == tg, bar);
            __builtin_amdgcn_fence(__ATOMIC_ACQUIRE, "agent");
            xb_add(&bar[XB_XGEN(b.x)], 1u);
            asm volatile("s_waitcnt vmcnt(0)" ::: "memory");
        } else {
            XB_SPIN(xb_ld(&bar[XB_XGEN(b.x)]) == gen, bar);
            __builtin_amdgcn_fence(__ATOMIC_ACQUIRE, "agent");
            asm volatile("s_waitcnt vmcnt(0)" ::: "memory");
        }
    }
    __syncthreads();
}


struct Args {
    const float* x_prompt; const float* x_sample; const float* cache_k; const float* cache_v; const float* cache_ik; const float* state_conv; const float* state_pool;
    const float* norm_g; const float* w_in; const float* conv_w; const float* conv_b; const float* pool_w; const float* pool_scale;
    const float* lift_a; const float* lift_b; const float* lift_c; const float* w_out; const float* final_g;
    float* out; unsigned char* ws;
};
struct Frame {
    LAS unsigned char* lds; volatile LAS unsigned* MISC; unsigned* ctl;
    int tid, lane, wave, vcu, G;
};
constexpr size_t O_Y = 0, O_KP = (size_t)M * DM, O_VP = O_KP + (size_t)2 * MP * 256, O_IKP = O_VP + (size_t)2 * MP * 256, O_CP = O_IKP + (size_t)2 * MP * 64, O_PP = O_CP + (size_t)2 * 8 * 2 * 512,
                 O_KS = O_PP + (size_t)2 * 8 * 15 * 512, O_VS = O_KS + (size_t)2 * MS * 256, O_IKS = O_VS + (size_t)2 * MS * 256, O_CS = O_IKS + (size_t)2 * MS * 64, O_PS = O_CS + (size_t)2 * 16 * 2 * 512, O_END = O_PS + (size_t)2 * 16 * 15 * 512;

__device__ const float c_inv[64] = { 1.0f, 0.8659643530845642f, 0.7498942017555237f, 0.6493816375732422f, 0.5623413324356079f, 0.486967533826828f, 0.4216965138912201f, 0.3651741147041321f, 0.3162277638912201f, 0.2738419771194458f, 0.23713737726211548f, 0.20535250008106232f, 0.17782793939113617f, 0.1539926528930664f, 0.1333521455526352f, 0.11547819525003433f, 0.10000000149011612f, 0.08659642934799194f, 0.0749894231557846f, 0.06493816524744034f, 0.05623413249850273f, 0.04869675263762474f, 0.04216964915394783f, 0.03651741147041321f, 0.03162277489900589f, 0.0273841954767704f, 0.023713737726211548f, 0.02053525112569332f, 0.017782794311642647f, 0.015399265103042126f, 0.013335213996469975f, 0.011547819711267948f, 0.009999999776482582f, 0.00865964312106371f, 0.007498942315578461f, 0.006493816152215004f, 0.005623413249850273f, 0.004869675263762474f, 0.0042169648222625256f, 0.0036517411936074495f, 0.003162277629598975f, 0.0027384196873754263f, 0.0023713738191872835f, 0.0020535250660032034f, 0.0017782794311642647f, 0.0015399265103042126f, 0.0013335214462131262f, 0.0011547820176929235f, 0.0010000000474974513f, 0.0008659643353894353f, 0.0007498941849917173f, 0.0006493816035799682f, 0.000562341301701963f, 0.0004869675321970135f, 0.0004216965171508491f, 0.00036517411353997886f, 0.0003162277571391314f, 0.00027384195709601045f, 0.00023713737027719617f, 0.00020535250951070338f, 0.00017782794020604342f, 0.0001539926597615704f, 0.0001333521504420787f, 0.00011547820031410083f };

__device__ __forceinline__ void sincos_rev(float ang, float& s, float& c) {
    float r = ang * 0.15915494309189535f; r = __builtin_amdgcn_fractf(r); s = __builtin_amdgcn_sinf(r); c = __builtin_amdgcn_cosf(r);
}

__device__ __forceinline__ int colmap_a(int np) {
    const int pn = np >> 8, jj = np & 255, half = jj >> 7, j = jj & 127;
    if (pn < 4)  return C_Q + (2 * pn + (j >> 6)) * 128 + (j & 63) + 64 * half;
    if (pn == 4) return C_K + (j >> 6) * 128 + (j & 63) + 64 * half;
    if (pn == 5) return C_V + jj;
    if (pn < 10) return C_IQ + (4 * (pn - 6) + (j >> 5)) * 64 + (j & 31) + 32 * half;
    if (pn == 10) { if (j < 32) return C_IK + j + 32 * half; if (half == 0 && j < 48) return C_IW + (j - 32); return -1; }
    if (pn < 15) return C_GA + (pn - 11) * 256 + jj;
    if (pn < 19) return (half ? C_CG : C_U) + (pn - 15) * 128 + j;
    if (pn < 23) return (half ? C_GB : C_BGT) + (pn - 19) * 128 + j;
    return (half ? C_GC : C_PIN) + (pn - 23) * 128 + j;
}
__device__ __forceinline__ void transpose_item(const float* W, int ldw, bf16* WT, int ldd, int koff, int k0, int n0, int src, LAS float* scr, int lane) {
#pragma unroll 8
    for (int i = 0; i < 32; ++i) { const int kk = 2 * i + (lane >> 5); scr[kk * 33 + (lane & 31)] = src >= 0 ? W[(size_t)(k0 + kk) * ldw + src] : 0.f; }
    LDS_WAIT(); asm volatile("" ::: "memory");
    const int c = lane & 7;
#pragma unroll
    for (int j = 0; j < 4; ++j) { const int n = (lane >> 3) + 8 * j; const LAS float* s = scr + (8 * c) * 33 + n;
        v4u o; o.x = cvt_pk_bf16(s[0 * 33], s[1 * 33]); o.y = cvt_pk_bf16(s[2 * 33], s[3 * 33]); o.z = cvt_pk_bf16(s[4 * 33], s[5 * 33]); o.w = cvt_pk_bf16(s[6 * 33], s[7 * 33]);
        *(GAS v4u*)(WT + (size_t)(n0 + n) * ldd + koff + k0 + 8 * c) = o; }
    LDS_WAIT(); asm volatile("" ::: "memory");
}
__device__ __forceinline__ void transpose_item_fp8(const float* W, int ldw, unsigned char* WT8, int ldd, int k0, int n0, int src, LAS float* scr, int lane) {
#pragma unroll 8
    for (int i = 0; i < 32; ++i) { const int kk = 2 * i + (lane >> 5); scr[kk * 33 + (lane & 31)] = W[(size_t)(k0 + kk) * ldw + src] * 64.0f; }
    LDS_WAIT(); asm volatile("" ::: "memory");
    const int c = lane & 7;
#pragma unroll
    for (int j = 0; j < 4; ++j) { const int n = (lane >> 3) + 8 * j; const LAS float* s = scr + (8 * c) * 33 + n;
        int w0 = __builtin_amdgcn_cvt_pk_fp8_f32(s[0 * 33], s[1 * 33], 0, false); w0 = __builtin_amdgcn_cvt_pk_fp8_f32(s[2 * 33], s[3 * 33], w0, true);
        int w1 = __builtin_amdgcn_cvt_pk_fp8_f32(s[4 * 33], s[5 * 33], 0, false); w1 = __builtin_amdgcn_cvt_pk_fp8_f32(s[6 * 33], s[7 * 33], w1, true);
        v2u o; o.x = (unsigned)w0; o.y = (unsigned)w1; *(GAS v2u*)(WT8 + (size_t)(n0 + n) * ldd + k0 + 8 * c) = o; }
    LDS_WAIT(); asm volatile("" ::: "memory");
}
__device__ __forceinline__ void cvt_stream(const float* src, bf16* dst, size_t n8, size_t i0, size_t stride) {
    for (size_t i = i0; i < n8; i += stride) { const f32x4 a = *(const GAS f32x4*)(src + i * 8), b = *(const GAS f32x4*)(src + i * 8 + 4);
        v4u o; o.x = cvt_pk_bf16(a[0], a[1]); o.y = cvt_pk_bf16(a[2], a[3]); o.z = cvt_pk_bf16(b[0], b[1]); o.w = cvt_pk_bf16(b[2], b[3]); *(GAS v4u*)(dst + i * 8) = o; }
}
template <bool OUT_BF16> __device__ __forceinline__ void rmsnorm_row(const float* xrow, const float* g, void* orow, int lane, unsigned char* orow8 = nullptr) {
    const GAS f32x4* xr = (const GAS f32x4*)xrow + lane; const GAS f32x4* gr = (const GAS f32x4*)g + lane;
    f32x4 v[8]; float s = 0.f;
#pragma unroll
    for (int j = 0; j < 8; ++j) { v[j] = xr[64 * j]; s += (v[j].x * v[j].x + v[j].y * v[j].y) + (v[j].z * v[j].z + v[j].w * v[j].w); }
    const float rstd = 1.0f / sqrtf(wave_sum(s) * (1.0f / DM) + EPS);
#pragma unroll
    for (int j = 0; j < 8; ++j) { const f32x4 gg = gr[64 * j]; const f32x4 y = v[j] * rstd * gg;
        if constexpr (OUT_BF16) { v2u o; o.x = cvt_pk_bf16(y.x, y.y); o.y = cvt_pk_bf16(y.z, y.w); ((GAS v2u*)orow)[lane + 64 * j] = o;
            int w8 = __builtin_amdgcn_cvt_pk_fp8_f32(y.x, y.y, 0, false); w8 = __builtin_amdgcn_cvt_pk_fp8_f32(y.z, y.w, w8, true); ((GAS unsigned*)orow8)[lane + 64 * j] = (unsigned)w8; }
        else ((GAS f32x4*)orow)[lane + 64 * j] = y; }
}
__device__ __forceinline__ void p0_prologue(const Frame& F, const Args& A, int l, const float* xp, const float* xs) {
    int tid = F.tid; asm volatile("" : "+v"(tid));
    const int lane = tid & 63, wave = __builtin_amdgcn_readfirstlane(tid >> 6);
    LAS float* scr = (LAS float*)(F.lds + wave * 16384);
    const int gw = F.vcu * NWAVES + wave, NGW = F.G * NWAVES;
    unsigned char* ws = A.ws;
    constexpr int I_A = 32 * (N1A / 32), I_B = 32 * (N1B / 32), I_LA = 16 * 64, I_LB = 8 * 64, I_LC = 8 * 64, I_O = 32 * 64, I_P = 4 * 2 * 4;
    constexpr int NIT = I_A + I_B + I_LA + I_LB + I_LC + I_O + I_P;
#ifndef P0REP
#define P0REP 0
#endif
    for (int rp = 0; rp < ((P0REP & 1) ? 2 : 1); ++rp)
    for (int it = gw; it < NIT; it += NGW) {
        int r = it;
        if (r < I_A) { const int kb = r / (N1A / 32), nb = r % (N1A / 32); transpose_item(A.w_in + (size_t)l * DM * IN_W, IN_W, (bf16*)(ws + WS_W1A), DM, 0, 64 * kb, 32 * nb, colmap_a(32 * nb + (lane & 31)), scr, lane); continue; } r -= I_A;
        if (r < I_B) { const int kb = r / (N1B / 32), nb = r % (N1B / 32); transpose_item_fp8(A.w_in + (size_t)l * DM * IN_W, IN_W, ws + WS_W8, DM, 64 * kb, 32 * nb, C_MA + 32 * nb + (lane & 31), scr, lane); continue; } r -= I_B;
        if (r < I_LA) { const int kb = r / 64, nb = r % 64; transpose_item(A.lift_a + (size_t)l * 1024 * DM, DM, (bf16*)(ws + WS_WL), DM, 0, 64 * kb, 32 * nb, 32 * nb + (lane & 31), scr, lane); continue; } r -= I_LA;
        if (r < I_LB) { const int kb = r / 64, nb = r % 64; transpose_item(A.lift_b + (size_t)l * 512 * DM, DM, (bf16*)(ws + WS_WL), DM, 1024, 64 * kb, 32 * nb, 32 * nb + (lane & 31), scr, lane); continue; } r -= I_LB;
        if (r < I_LC) { const int kb = r / 64, nb = r % 64; transpose_item(A.lift_c + (size_t)l * 512 * DM, DM, (bf16*)(ws + WS_WL), DM, 1536, 64 * kb, 32 * nb, 32 * nb + (lane & 31), scr, lane); continue; } r -= I_LC;
        if (r < I_O) { const int kb = r / 64, nb = r % 64; transpose_item(A.w_out + (size_t)l * DM * DM, DM, (bf16*)(ws + WS_WO), DM, 0, 64 * kb, 32 * nb, 32 * nb + (lane & 31), scr, lane); continue; } r -= I_O;
        { const int g = r / 8, kb = (r % 8) / 4, nb = r % 4; transpose_item(A.pool_w + (size_t)(l * 4 + g) * 128 * 128, 128, (bf16*)(ws + WS_PW) + g * 128 * 128, 128, 0, 64 * kb, 32 * nb, 32 * nb + (lane & 31), scr, lane); }
    }
    for (int rp = 0; rp < ((P0REP & 2) ? 2 : 1); ++rp)
    {
        const size_t i0 = (size_t)gw * 64 + lane, st = (size_t)NGW * 64;
        cvt_stream(A.cache_k + (size_t)l * NB_S * PAST * 256, (bf16*)(ws + WS_CK), (size_t)NB_S * PAST * 256 / 8, i0, st);
        cvt_stream(A.cache_v + (size_t)l * NB_S * PAST * 256, (bf16*)(ws + WS_CV), (size_t)NB_S * PAST * 256 / 8, i0, st);
        cvt_stream(A.cache_ik + (size_t)l * NB_S * PAST * 64, (bf16*)(ws + WS_CIK), (size_t)NB_S * PAST * 64 / 8, i0, st);
    }
    const float* g = A.norm_g + (size_t)l * DM; bf16* H = (bf16*)(ws + WS_H);
    for (int rp = 0; rp < ((P0REP & 4) ? 2 : 1); ++rp)
    for (int m = gw; m < M; m += NGW) rmsnorm_row<true>(m < MP ? xp + (size_t)m * DM : xs + (size_t)(m - MP) * DM, g, H + (size_t)m * DM, lane, ws + WS_H8 + (size_t)m * DM);
}

typedef pg8::Unit Unit;
#define ACCV(ai, bj, m, i) acc[ai][bj][m][(i) >> 2][(i) & 3]
__device__ __forceinline__ void st_f32x8(float* p, const float (&v)[8]) { *(GAS f32x4*)p = (f32x4){v[0], v[1], v[2], v[3]}; *(GAS f32x4*)(p + 4) = (f32x4){v[4], v[5], v[6], v[7]}; }
__device__ __forceinline__ void st_bf16x8(bf16* p, const float (&v)[8]) { *(GAS v4u*)p = pack8(v); }

struct EpiP1 {
    static constexpr bool PERM = true, AFTER_DRAIN = false, FP8 = false; static constexpr int NSEG = 1;
    bf16 *Qb, *Kb, *Vb, *IQb, *IKb, *Y, *CIN, *PIN; float* IW;
    float *k_p, *k_s, *v_p, *v_s, *ik_p, *ik_s, *cv_p, *cv_s, *pl_p, *pl_s;
    __device__ __forceinline__ void operator()(const f32x4 (&acc)[2][2][4][2], const Unit& u, int wr, int wc, int fr, int fq) const {
        asm volatile("" : "+v"(fr), "+v"(fq));
        const int pn = u.pn; const bool smp = u.pm >= MP / 256;
        const int rbase = u.pm * 256 + wr * 64 + fr, j0 = wc * 32 + fq * 8;
        if (pn <= 4 || (pn >= 6 && pn <= 9) || (pn == 10 && wc == 0)) {
            const bool idx = pn >= 6; float inv[8];
#pragma unroll
            for (int i = 0; i < 8; ++i) inv[i] = idx ? c_inv[2 * ((j0 & 31) + i)] : c_inv[(j0 & 63) + i];
#pragma unroll
            for (int ai = 0; ai < 2; ++ai)
#pragma unroll
                for (int m = 0; m < 4; ++m) {
                    const int row = rbase + ai * 128 + m * 16; const float pos = (float)(smp ? PAST + (row & 63) : (row & (SEQ - 1)));
                    float o1[8], o2[8];
#pragma unroll
                    for (int i = 0; i < 8; ++i) { float s, c; sincos_rev(pos * inv[i], s, c); const float x1 = ACCV(ai, 0, m, i), x2 = ACCV(ai, 1, m, i); o1[i] = x1 * c - x2 * s; o2[i] = x2 * c + x1 * s; }
                    if (pn < 4) { bf16* p = Qb + (size_t)row * 1024 + (2 * pn + (j0 >> 6)) * 128 + (j0 & 63); st_bf16x8(p, o1); st_bf16x8(p + 64, o2); }
                    else if (pn == 4) { const int off = (j0 >> 6) * 128 + (j0 & 63); bf16* p = Kb + (size_t)row * 256 + off; st_bf16x8(p, o1); st_bf16x8(p + 64, o2);
                        float* q = (smp ? k_s + (size_t)(row - MP) * 256 : k_p + (size_t)row * 256) + off; st_f32x8(q, o1); st_f32x8(q + 64, o2); }
                    else if (pn < 10) { bf16* p = IQb + (size_t)row * 1024 + (4 * (pn - 6) + (j0 >> 5)) * 64 + (j0 & 31); st_bf16x8(p, o1); st_bf16x8(p + 32, o2); }
                    else { bf16* p = IKb + (size_t)row * 64 + j0; st_bf16x8(p, o1); st_bf16x8(p + 32, o2);
                        float* q = (smp ? ik_s + (size_t)(row - MP) * 64 : ik_p + (size_t)row * 64) + j0; st_f32x8(q, o1); st_f32x8(q + 32, o2); }
                }
            return;
        }
#pragma unroll
        for (int ai = 0; ai < 2; ++ai)
#pragma unroll
            for (int m = 0; m < 4; ++m) {
                const int row = rbase + ai * 128 + m * 16; float a[8], b[8];
#pragma unroll
                for (int i = 0; i < 8; ++i) { a[i] = ACCV(ai, 0, m, i); b[i] = ACCV(ai, 1, m, i); }
                if (pn == 5) {
                    bf16* p = Vb + (size_t)row * 256 + j0; st_bf16x8(p, a); st_bf16x8(p + 128, b);
                    float* q = (smp ? v_s + (size_t)(row - MP) * 256 : v_p + (size_t)row * 256) + j0; st_f32x8(q, a); st_f32x8(q + 128, b);
                } else if (pn == 10) {
                    if (wc == 1 && fq < 2) { float* q = IW + (size_t)row * 16 + 8 * fq;
#pragma unroll
                        for (int i = 0; i < 8; ++i) a[i] *= 0.03125f;
                        st_f32x8(q, a); }
                } else if (pn < 15) {
#pragma unroll
                    for (int i = 0; i < 8; ++i) { a[i] = siluf_(a[i]); b[i] = siluf_(b[i]); }
                    bf16* p = Y + (size_t)row * DM + (pn - 11) * 256 + j0; st_bf16x8(p, a); st_bf16x8(p + 128, b);
                } else if (pn < 19) {
#pragma unroll
                    for (int i = 0; i < 8; ++i) a[i] *= b[i];
                    const int col = (pn - 15) * 128 + j0; st_bf16x8(CIN + (size_t)row * 512 + col, a);
                    const int t = smp ? (row & 63) : (row & (SEQ - 1)), T = smp ? DSEQ : SEQ;
                    if (t >= T - 2) { float* q = smp ? cv_s + ((size_t)((row - MP) >> 6) * 2 + (t - (T - 2))) * 512 + col : cv_p + ((size_t)(row >> 12) * 2 + (t - (T - 2))) * 512 + col; st_f32x8(q, a); }
                } else if (pn < 23) {
#pragma unroll
                    for (int i = 0; i < 8; ++i) a[i] *= siluf_(b[i]);
                    st_bf16x8(Y + (size_t)row * DM + 1024 + (pn - 19) * 128 + j0, a);
                } else {
                    const int col = (pn - 23) * 128 + j0; st_bf16x8(PIN + (size_t)row * 512 + col, a);
                    const int t = smp ? (row & 63) : (row & (SEQ - 1)), T = smp ? DSEQ : SEQ;
                    if (t >= T - 15) { float* q = smp ? pl_s + ((size_t)((row - MP) >> 6) * 15 + (t - (T - 15))) * 512 + col : pl_p + ((size_t)(row >> 12) * 15 + (t - (T - 15))) * 512 + col; st_f32x8(q, a); }
#pragma unroll
                    for (int i = 0; i < 8; ++i) b[i] = siluf_(b[i]);
                    st_bf16x8(Y + (size_t)row * DM + 1536 + col, b);
                }
            }
    }
};
typedef unsigned char u8;
__device__ __forceinline__ unsigned gate_q(float x) { const float q = __builtin_rintf(255.0f * sigmoidf_(x * 0.015625f)); return (unsigned)(q < 1.0f ? 1.0f : q); }
__device__ __forceinline__ void unpack_u8x8(v2u w, float (&v)[8]) {
    v[0] = (float)(w.x & 255u); v[1] = (float)((w.x >> 8) & 255u); v[2] = (float)((w.x >> 16) & 255u); v[3] = (float)(w.x >> 24);
    v[4] = (float)(w.y & 255u); v[5] = (float)((w.y >> 8) & 255u); v[6] = (float)((w.y >> 16) & 255u); v[7] = (float)(w.y >> 24); }
struct EpiP3 {
    static constexpr bool PERM = true, AFTER_DRAIN = false, FP8 = true; static constexpr int NSEG = 1;
    u8* G;
    __device__ __forceinline__ void operator()(const f32x4 (&acc)[2][2][4][2], const Unit& u, int wr, int wc, int fr, int fq) const {
        asm volatile("" : "+v"(fr), "+v"(fq));
        const int rbase = u.pm * 256 + wr * 64 + fr, c0 = u.pn * 256 + wc * 32 + fq * 8;
#pragma unroll
        for (int ai = 0; ai < 2; ++ai)
#pragma unroll
            for (int m = 0; m < 4; ++m) { u8* p = G + (size_t)(rbase + ai * 128 + m * 16) * N1B + c0;
#pragma unroll
                for (int bj = 0; bj < 2; ++bj) { v2u w;
                    w.x = gate_q(ACCV(ai, bj, m, 0)) | (gate_q(ACCV(ai, bj, m, 1)) << 8) | (gate_q(ACCV(ai, bj, m, 2)) << 16) | (gate_q(ACCV(ai, bj, m, 3)) << 24);
                    w.y = gate_q(ACCV(ai, bj, m, 4)) | (gate_q(ACCV(ai, bj, m, 5)) << 8) | (gate_q(ACCV(ai, bj, m, 6)) << 16) | (gate_q(ACCV(ai, bj, m, 7)) << 24);
                    *(GAS v2u*)(p + bj * 128) = w; } }
    }
};
struct EpiP4 {
    static constexpr bool PERM = true, AFTER_DRAIN = false, FP8 = false; static constexpr int NSEG = 4;
    const u8* G; bf16* Z;
    __device__ __forceinline__ void operator()(f32x4 (&acc)[2][2][4][2], const Unit& u, int wr, int wc, int fr, int fq) const {
        asm volatile("" : "+v"(fr), "+v"(fq));
        if (u.seg == 0) return;
        const int rbase = u.pm * 256 + wr * 64 + fr, c0 = u.pn * 256 + wc * 32 + fq * 8;
        if (u.seg < 3) {
            const int o1 = u.seg == 1 ? 0 : DM;
#pragma unroll
            for (int ai = 0; ai < 2; ++ai)
#pragma unroll
                for (int m = 0; m < 4; ++m) { const u8* p = G + (size_t)(rbase + ai * 128 + m * 16) * N1B + c0 + o1;
#pragma unroll
                    for (int bj = 0; bj < 2; ++bj) { float ga[8], gb[8]; unpack_u8x8(*(const GAS v2u*)(p + bj * 128), ga); unpack_u8x8(*(const GAS v2u*)(p + bj * 128 + DM), gb);
#pragma unroll
                        for (int i = 0; i < 8; ++i) ACCV(ai, bj, m, i) *= ga[i] * __builtin_amdgcn_rcpf(gb[i]); } }
            return;
        }
#pragma unroll
        for (int ai = 0; ai < 2; ++ai) {
            v2u gv[4][2];
#pragma unroll
            for (int m = 0; m < 4; ++m) { const u8* p = G + (size_t)(rbase + ai * 128 + m * 16) * N1B + 2 * DM + c0; gv[m][0] = *(const GAS v2u*)p; gv[m][1] = *(const GAS v2u*)(p + 128); }
            asm volatile("" ::: "memory");
#pragma unroll
            for (int m = 0; m < 4; ++m)
#pragma unroll
                for (int bj = 0; bj < 2; ++bj) { float gc[8], a[8]; unpack_u8x8(gv[m][bj], gc);
#pragma unroll
                    for (int i = 0; i < 8; ++i) a[i] = ACCV(ai, bj, m, i) * (gc[i] * (1.0f / 255.0f));
                    st_bf16x8(Z + (size_t)(rbase + ai * 128 + m * 16) * DM + c0 + bj * 128, a); }
        }
    }
};
struct EpiP5 {
    static constexpr bool PERM = false, AFTER_DRAIN = false, FP8 = false; static constexpr int NSEG = 1;
    const float* xp; const float* xs; float* out;
    __device__ __forceinline__ void operator()(const f32x4 (&acc)[2][2][4][2], const Unit& u, int wr, int wc, int fr, int fq) const {
        asm volatile("" : "+v"(fr), "+v"(fq));
        const int rbase = u.pm * 256 + wr * 64 + fr, c0 = u.pn * 256 + wc * 32 + 4 * fq;
#pragma unroll
        for (int ai = 0; ai < 2; ++ai) {
            f32x4 xv[4][2][2];
#pragma unroll
            for (int m = 0; m < 4; ++m) { const int row = rbase + ai * 128 + m * 16; const float* xr = (row < MP ? xp + (size_t)row * DM : xs + (size_t)(row - MP) * DM) + c0;
#pragma unroll
                for (int bj = 0; bj < 2; ++bj)
#pragma unroll
                    for (int n = 0; n < 2; ++n) xv[m][bj][n] = *(const GAS f32x4*)(xr + bj * 128 + n * 16); }
            asm volatile("" ::: "memory");
#pragma unroll
            for (int m = 0; m < 4; ++m) { float* orow = out + (size_t)(rbase + ai * 128 + m * 16) * DM + c0;
#pragma unroll
                for (int bj = 0; bj < 2; ++bj)
#pragma unroll
                    for (int n = 0; n < 2; ++n) *(GAS f32x4*)(orow + bj * 128 + n * 16) = xv[m][bj][n] + acc[ai][bj][m][n]; }
            asm volatile("" ::: "memory");
        }
    }
};

#ifndef P2PARTS
#define P2PARTS 15
#endif
#ifndef P2REP
#define P2REP 0
#endif
struct P2Ctx {
    const bf16 *Qb, *Kb, *Vb, *IQb, *IKb, *CKb, *CVb, *CIKb, *CIN, *PIN, *PWt; const float* IW; bf16* Y;
    const float *state_conv, *state_pool, *conv_w, *conv_b, *pool_scale;
    unsigned short* S;
    bool rt_true;
};
struct AttnItem { int smp, b, m0, nt, ntp; };
constexpr int SHM_V = 64 * 128 * 2, SHM_K = 64 * 128 * 2, SHM_WS = 2 * SHM_V + 2 * SHM_K;
constexpr int ATT_W = SHM_WS + NWAVES * 256;
constexpr int ATT_QP = ATT_W + 64 * MW * 8;
#ifndef QPARK
#define QPARK 6
#endif
static_assert(ATT_QP + QPARK * 8192 <= LDSCTL_OFF, "attention LDS");
#define KSWZ(row, colB) ((row) * 256 + ((colB) ^ (((row) & 7) << 4)))
#define SBAR() __builtin_amdgcn_sched_barrier(0)
__device__ __forceinline__ int crow(int r, int hi) { return (r & 3) + 8 * (r >> 2) + 4 * hi; }
__device__ __forceinline__ bf16x8 ld8(const bf16* p) { return *reinterpret_cast<const bf16x8*>(p); }
__device__ __forceinline__ int voff(int row, int sc) { return (row >> 5) * 8192 + 2 * ((sc >> 4) * 512 + (row & 31) * 16 + (sc & 8)); }
__device__ __forceinline__ const bf16* kv_tile(const AttnItem& it, const bf16* newb, const bf16* cacheb, int kt, int pitch) {
    if (kt >= it.nt) kt = 0;
    if (it.smp) return kt < PAST / 64 ? cacheb + ((size_t)it.b * PAST + 64 * kt) * pitch : newb + (size_t)it.m0 * pitch;
    return newb + ((size_t)it.b * SEQ + 64 * kt) * pitch;
}
__device__ __forceinline__ unsigned wave_total_u32(unsigned v) {
    v += (unsigned)__builtin_amdgcn_update_dpp(0, (int)v, 0xB1, 0xF, 0xF, true);
    v += (unsigned)__builtin_amdgcn_update_dpp(0, (int)v, 0x4E, 0xF, 0xF, true);
    v += (unsigned)__builtin_amdgcn_update_dpp(0, (int)v, 0x141, 0xF, 0xF, true);
    v += (unsigned)__builtin_amdgcn_update_dpp(0, (int)v, 0x140, 0xF, 0xF, true);
    return (unsigned)__builtin_amdgcn_readlane((int)v, 0) + (unsigned)__builtin_amdgcn_readlane((int)v, 16) + (unsigned)__builtin_amdgcn_readlane((int)v, 32) + (unsigned)__builtin_amdgcn_readlane((int)v, 48);
}

__device__ __forceinline__ void a1_scores(char* shm, const AttnItem& it, const P2Ctx& C, int tid, int wid, int lane) {
    asm volatile("" : "+v"(tid)); lane = tid & 63; wid = __builtin_amdgcn_readfirstlane(tid >> 6);
    const int r32 = lane & 31, hi = lane >> 5;
    bf16x8 a[4][4]; float w[4][16];
#pragma unroll
    for (int p = 0; p < 4; ++p) {
        const int q = 8 * wid + 2 * p + ((r32 >> 2) & 1), head = 4 * (r32 >> 3) + (r32 & 3);
        const bf16* src = C.IQb + (size_t)(it.m0 + q) * 1024 + head * 64 + hi * 8;
#pragma unroll
        for (int ks = 0; ks < 4; ++ks) a[p][ks] = ld8(src + ks * 16);
        const float* wp = C.IW + (size_t)(it.m0 + 8 * wid + 2 * p + hi) * 16;
#pragma unroll
        for (int j = 0; j < 4; ++j) { const f32x4 t = *(const GAS f32x4*)(wp + 4 * j); w[p][4 * j] = t[0]; w[p][4 * j + 1] = t[1]; w[p][4 * j + 2] = t[2]; w[p][4 * j + 3] = t[3]; }
    }
    const int skey = tid >> 3, sch = tid & 7, sdst = skey * 128 + ((sch ^ ((skey >> 1) & 7)) << 4);
#define A1_LD(kt_) (*(const GAS v4u*)(kv_tile(it, C.IKb, C.CIKb, (kt_), 64) + skey * 64 + sch * 8))
    {   const v4u t0 = A1_LD(0); *(v4u*)(shm + sdst) = t0; }
    v4u st0 = {0u, 0u, 0u, 0u}, st1 = st0, st2 = st0, st3 = st0;
    if (1 < it.nt) st0 = A1_LD(1);
    if (2 < it.nt) st1 = A1_LD(2);
    if (3 < it.nt) st2 = A1_LD(3);
    __syncthreads();
    for (int kt = 0; kt < it.nt; ++kt) {
        const bool more = kt + 1 < it.nt;
        if (kt + 4 < it.nt) st3 = A1_LD(kt + 4);
        const char* buf = shm + (kt & 1) * 8192;
        bf16x8 b[4];
#define A1_LDB(ct_) do { const int key_ = 32 * (ct_) + r32; _Pragma("unroll") for (int ks = 0; ks < 4; ++ks) b[ks] = *reinterpret_cast<const bf16x8*>(buf + key_ * 128 + (((2 * ks + hi) ^ ((key_ >> 1) & 7)) << 4)); } while (0)
        A1_LDB(0);
        f32x16 cc[2];
#define A1_MFMA(dst, st) do { dst = f32x16{}; _Pragma("unroll") for (int ks = 0; ks < 4; ++ks) dst = __builtin_amdgcn_mfma_f32_32x32x16_bf16(a[(st) & 3][ks], b[ks], dst, 0, 0, 0); } while (0)
        A1_MFMA(cc[0], 0);
#pragma unroll
        for (int st = 0; st < 8; ++st) {
            if (st == 3) A1_LDB(1);
            if (st + 1 < 8) A1_MFMA(cc[(st + 1) & 1], st + 1);
            __builtin_amdgcn_sched_barrier(0);
            const int p = st & 3, ct = st >> 2; const f32x16& c = cc[st & 1];
            float s0 = 0.f, s1 = 0.f;
#pragma unroll
            for (int r = 0; r < 16; r += 2) { const int c0i = __float_as_int(c[r]), c1i = __float_as_int(c[r + 1]);
                s0 = fmaf(__int_as_float(c0i > 0 ? c0i : 0), w[p][r], s0); s1 = fmaf(__int_as_float(c1i > 0 ? c1i : 0), w[p][r + 1], s1); }
            const float sc = s0 + s1;
            const unsigned hb = (unsigned)__builtin_bit_cast(unsigned short, (_Float16)sc);
            C.S[(size_t)(8 * wid + 2 * p + hi) * SLD + 64 * kt + 32 * ct + r32] = (unsigned short)((hb ^ ((hb & 0x8000u) ? 0xffffu : 0x8000u)) >> 1);
            __builtin_amdgcn_sched_barrier(0);
        }
#undef A1_MFMA
#undef A1_LDB
        if (more) *(v4u*)(shm + ((kt + 1) & 1) * 8192 + sdst) = st0;
        st0 = st1; st1 = st2; st2 = st3;
        __syncthreads();
    }
#undef A1_LD
}
template <int NREG> __device__ __forceinline__ void a2_select(const unsigned short* srow, int nt, LAS unsigned long long* Wq, int lane) {
    unsigned x[NREG];
#pragma unroll
    for (int i = 0; i < NREG; ++i) x[i] = __builtin_nontemporal_load((const unsigned*)srow + 64 * i + lane);
    __builtin_amdgcn_sched_barrier(0);
#pragma unroll
    for (int i = 0; i < NREG; ++i) x[i] = (2 * i + (lane >> 5) < nt) ? (x[i] | 0x80008000u) : 0x80008000u;
    unsigned T = 0u, cntT = 0u;
#pragma unroll 1
    for (int bit = 14; bit >= 0; --bit) {
        const unsigned cand = T | (1u << bit), cc = cand | (cand << 16); unsigned c = 0;
#pragma unroll
        for (int i = 0; i < NREG; ++i) c += (unsigned)__builtin_popcount((x[i] - cc) & 0x80008000u);
        c = wave_total_u32(c);
        if (c >= 256u) { T = cand; cntT = c; if (c == 256u) break; }
    }
    const unsigned cT = T | (T << 16);
    if (cntT == 256u) {
#pragma unroll
        for (int i = 0; i < NREG; ++i) { const unsigned d = x[i] - cT; const unsigned long long b0 = __ballot((d & 0x8000u) != 0u), b1 = __ballot((d & 0x80000000u) != 0u);
            if (lane == 0) { if (2 * i < nt) Wq[2 * i] = (b0 & 0xffffffffull) | (b1 << 32); if (2 * i + 1 < nt) Wq[2 * i + 1] = (b0 >> 32) | (b1 & 0xffffffff00000000ull); } }
    } else {
        unsigned g = 0; const unsigned c1 = cT + 0x00010001u;
#pragma unroll
        for (int i = 0; i < NREG; ++i) g += (unsigned)__builtin_popcount((x[i] - c1) & 0x80008000u);
        g = wave_total_u32(g);
        const unsigned need = 256u - g; unsigned ceq = 0u;
#pragma unroll
        for (int i = 0; i < NREG; ++i) {
            const unsigned klo = x[i] & 0x7fffu, khi = (x[i] >> 16) & 0x7fffu;
            const bool elo = klo == T, ehi = khi == T;
            const unsigned long long qlo = __ballot(elo), qhi = __ballot(ehi);
            const unsigned base = ceq + __builtin_amdgcn_mbcnt_hi((unsigned)(qlo >> 32), __builtin_amdgcn_mbcnt_lo((unsigned)qlo, 0u)) + __builtin_amdgcn_mbcnt_hi((unsigned)(qhi >> 32), __builtin_amdgcn_mbcnt_lo((unsigned)qhi, 0u));
            const unsigned long long b0 = __ballot(klo > T || (elo && base < need)), b1 = __ballot(khi > T || (ehi && base + (elo ? 1u : 0u) < need));
            if (lane == 0) { if (2 * i < nt) Wq[2 * i] = (b0 & 0xffffffffull) | (b1 << 32); if (2 * i + 1 < nt) Wq[2 * i + 1] = (b0 >> 32) | (b1 & 0xffffffff00000000ull); }
            ceq += (unsigned)__popcll(qlo) + (unsigned)__popcll(qhi);
        }
    }
}
__device__ __forceinline__ void partialSM(f32x16& p0, f32x16& p1, float& m_reg, float& msub, float& alpha, unsigned long long wq, int hi) {
    constexpr float SL2E = 0.088388347648318447f * 1.4426950408889634f, THR2 = 8.0f * 1.4426950408889634f;
    const float ninf = -__builtin_inff(); const unsigned we = (unsigned)wq >> (2 * hi), wo = (unsigned)(wq >> 32) >> (2 * hi);
#pragma unroll
    for (int r = 0; r < 16; ++r) { const int c = ((r >> 1) & 1) + 4 * (r >> 2); const unsigned w = (r & 1) ? wo : we; p0[r] = ((w >> c) & 1u) ? p0[r] : ninf; p1[r] = ((w >> (c + 16)) & 1u) ? p1[r] : ninf; }
    float pmax = p0[0];
#pragma unroll
    for (int r = 1; r < 16; ++r) pmax = fmaxf(pmax, p0[r]);
#pragma unroll
    for (int r = 0; r < 16; ++r) pmax = fmaxf(pmax, p1[r]);
    { auto rr = __builtin_amdgcn_permlane32_swap(__float_as_uint(pmax), __float_as_uint(pmax), false, false); pmax = fmaxf(__uint_as_float(rr[0]), __uint_as_float(rr[1])); }
    pmax *= SL2E;
    if (__builtin_expect(__all(pmax - m_reg <= THR2), 1)) { alpha = 1.f; }
    else { float mn = fmaxf(m_reg, pmax); msub = (mn == -__builtin_inff()) ? 0.f : mn; alpha = __builtin_amdgcn_exp2f(m_reg - msub); m_reg = mn; }
    const float nm = -msub;
#pragma unroll
    for (int r = 0; r < 16; ++r) p0[r] = fmaf(p0[r], SL2E, nm);
#pragma unroll
    for (int r = 0; r < 16; ++r) p1[r] = fmaf(p1[r], SL2E, nm);
#pragma unroll
    for (int r = 0; r < 16; ++r) p0[r] = __builtin_amdgcn_exp2f(p0[r]);
}
__device__ __forceinline__ void finishSM(f32x16& p0, f32x16& p1, float alpha, float& l_reg, bf16x8& pa0, bf16x8& pa1, bf16x8& pa2, bf16x8& pa3) {
#pragma unroll
    for (int r = 0; r < 16; ++r) p1[r] = __builtin_amdgcn_exp2f(p1[r]);
    float ps = 0;
#pragma unroll
    for (int r = 0; r < 16; ++r) ps += p0[r];
#pragma unroll
    for (int r = 0; r < 16; ++r) ps += p1[r];
    { auto rr = __builtin_amdgcn_permlane32_swap(__float_as_uint(ps), __float_as_uint(ps), false, false); ps = __uint_as_float(rr[0]) + __uint_as_float(rr[1]); }
    l_reg = l_reg * alpha + ps;
#define PK4(P, BASE, OUT) do { unsigned a0 = cvt_pk_bf16(P[BASE + 0], P[BASE + 1]), a1 = cvt_pk_bf16(P[BASE + 2], P[BASE + 3]); \
    unsigned b0 = cvt_pk_bf16(P[BASE + 4], P[BASE + 5]), b1 = cvt_pk_bf16(P[BASE + 6], P[BASE + 7]); \
    auto r0 = __builtin_amdgcn_permlane32_swap(a0, b0, false, false); auto r1 = __builtin_amdgcn_permlane32_swap(a1, b1, false, false); \
    v4u w = {r0[0], r1[0], r0[1], r1[1]}; OUT = *reinterpret_cast<bf16x8*>(&w); } while (0)
    PK4(p0, 0, pa0); PK4(p0, 8, pa1); PK4(p1, 0, pa2); PK4(p1, 8, pa3);
#undef PK4
}
__device__ __forceinline__ void qkt(f32x16& p0, f32x16& p1, const char* Ks, const bf16x8* qr, const char* qp, int r32, int hi) {
    p0 = f32x16{}; p1 = f32x16{};
#pragma unroll
    for (int d0 = 0; d0 < 8; ++d0) { const int cb = (d0 * 16 + hi * 8) * 2;
        const bf16x8 b0 = *reinterpret_cast<const bf16x8*>(Ks + KSWZ(r32, cb));
        const bf16x8 b1 = *reinterpret_cast<const bf16x8*>(Ks + KSWZ(32 + r32, cb));
        const bf16x8 q = d0 < 8 - QPARK ? qr[d0] : *reinterpret_cast<const bf16x8*>(qp + (d0 - (8 - QPARK)) * 8192);
        p0 = __builtin_amdgcn_mfma_f32_32x32x16_bf16(b0, q, p0, 0, 0, 0);
        p1 = __builtin_amdgcn_mfma_f32_32x32x16_bf16(b1, q, p1, 0, 0, 0); }
}
template <int OFF> __device__ __forceinline__ s16x4 trrd(int vb) { s16x4 r; asm volatile("ds_read_b64_tr_b16 %0,%1 offset:%2" : "=&v"(r) : "v"(vb), "n"(OFF) : "memory"); return r; }
template <int BUF, int D0> __device__ __forceinline__ void pv_one(f32x16& o, int vb, bf16x8 pa0, bf16x8 pa1, bf16x8 pa2, bf16x8 pa3) {
    constexpr int B0 = BUF * SHM_V + D0 * 2048;
    const s16x4 lo0 = trrd<B0>(vb), hi0 = trrd<B0 + 128>(vb), lo1 = trrd<B0 + 512>(vb), hi1 = trrd<B0 + 512 + 128>(vb);
    const s16x4 lo2 = trrd<B0 + 8192>(vb), hi2 = trrd<B0 + 8192 + 128>(vb), lo3 = trrd<B0 + 8192 + 512>(vb), hi3 = trrd<B0 + 8192 + 512 + 128>(vb);
    asm volatile("s_waitcnt lgkmcnt(0)" ::: "memory"); SBAR();
#define PK(l, h) (bf16x8){l[0], l[1], l[2], l[3], h[0], h[1], h[2], h[3]}
    o = __builtin_amdgcn_mfma_f32_32x32x16_bf16(pa0, PK(lo0, hi0), o, 0, 0, 0);
    o = __builtin_amdgcn_mfma_f32_32x32x16_bf16(pa1, PK(lo1, hi1), o, 0, 0, 0);
    o = __builtin_amdgcn_mfma_f32_32x32x16_bf16(pa2, PK(lo2, hi2), o, 0, 0, 0);
    o = __builtin_amdgcn_mfma_f32_32x32x16_bf16(pa3, PK(lo3, hi3), o, 0, 0, 0);
#undef PK
}
template <int BUF> __device__ __forceinline__ void pv_d0(f32x16* o, int vb, bf16x8 pa0, bf16x8 pa1, bf16x8 pa2, bf16x8 pa3) {
    pv_one<BUF, 0>(o[0], vb, pa0, pa1, pa2, pa3); pv_one<BUF, 1>(o[1], vb, pa0, pa1, pa2, pa3); pv_one<BUF, 2>(o[2], vb, pa0, pa1, pa2, pa3); pv_one<BUF, 3>(o[3], vb, pa0, pa1, pa2, pa3);
}
__device__ __forceinline__ void attn_head(char* shm, const AttnItem& it, const P2Ctx& C, int kvh, int tid, int wid, int lane, bool store) {
    asm volatile("" : "+v"(tid)); lane = tid & 63; wid = __builtin_amdgcn_readfirstlane(tid >> 6);
    const int r32 = lane & 31, hi = lane >> 5;
    char* V_lds = shm; char* K_lds = shm + 2 * SHM_V;
    float* wsx = (float*)(shm + SHM_WS) + wid * 64; float* li_l = wsx; float* al_l = wsx + 32;
    const unsigned long long* Wl = (const unsigned long long*)(shm + ATT_W);
    const int pos = 32 * (wid & 1) + r32, head = kvh * 4 + (wid >> 1);
    const unsigned long long* Wrow = Wl + pos * MW;
    const bf16* qrow = C.Qb + (size_t)(it.m0 + pos) * 1024 + head * 128;
    bf16x8 qr[8]; char* qp = shm + ATT_QP + tid * 16;
    float m_reg = -__builtin_inff(), msub = 0.f, l_reg = 0.f; f32x16 o[4] = {};
    const int sr = tid >> 4, sc = (tid & 15) * 8;
    const int vb0 = (int)(uintptr_t)V_lds + (lane & 15) * 8 + ((lane >> 4) & 1) * 1024 + (lane >> 5) * 256;
    bf16x8 sv0, sv1, sk0, sk1;
    const int TPS = it.ntp;
#define SLOAD(kt) do { const bf16* Kt_ = kv_tile(it, C.Kb, C.CKb, (kt), 256) + kvh * 128 + sc; const bf16* Vt_ = kv_tile(it, C.Vb, C.CVb, (kt), 256) + kvh * 128 + sc; \
    sv0 = ld8(Vt_ + (size_t)sr * 256); sv1 = ld8(Vt_ + (size_t)(32 + sr) * 256); sk0 = ld8(Kt_ + (size_t)sr * 256); sk1 = ld8(Kt_ + (size_t)(32 + sr) * 256); } while (0)
#define SWRITE(buf) do { *(bf16x8*)(V_lds + (buf) * SHM_V + voff(sr, sc)) = sv0; *(bf16x8*)(V_lds + (buf) * SHM_V + voff(32 + sr, sc)) = sv1; const int kc = sc * 2; \
    *(bf16x8*)(K_lds + (buf) * SHM_K + KSWZ(sr, kc)) = sk0; *(bf16x8*)(K_lds + (buf) * SHM_K + KSWZ(32 + sr, kc)) = sk1; } while (0)
#define RESC(a) do { if (__any((a) < 1.f)) { if (hi == 0) al_l[r32] = (a); asm volatile("s_waitcnt lgkmcnt(0)" ::: "memory"); \
    _Pragma("unroll") for (int d = 0; d < 4; ++d) _Pragma("unroll") for (int r = 0; r < 16; ++r) o[d][r] *= al_l[crow(r, hi)]; } } while (0)
    f32x16 pA0, pA1, pB0, pB1; float alA, alB; bf16x8 pa0, pa1, pa2, pa3;
#pragma unroll
    for (int d0 = 0; d0 < 8; ++d0) qr[d0] = ld8(qrow + d0 * 16 + hi * 8);
#pragma unroll
    for (int j = 0; j < QPARK; ++j) *reinterpret_cast<bf16x8*>(qp + j * 8192) = qr[8 - QPARK + j];
    SLOAD(0); SWRITE(0); __syncthreads();
    qkt(pA0, pA1, K_lds, qr, qp, r32, hi); partialSM(pA0, pA1, m_reg, msub, alA, Wrow[0], hi);
    SLOAD(1); SWRITE(1); __syncthreads();
    for (int j = 1; j + 1 < TPS; j += 2) {
        SBAR(); qkt(pB0, pB1, K_lds + SHM_K, qr, qp, r32, hi);
        finishSM(pA0, pA1, alA, l_reg, pa0, pa1, pa2, pa3); SBAR();
        SLOAD(j + 1); SBAR();
        pv_d0<0>(o, vb0, pa0, pa1, pa2, pa3); partialSM(pB0, pB1, m_reg, msub, alB, Wrow[j], hi);
        __syncthreads(); asm volatile("s_waitcnt vmcnt(0)" ::: "memory"); SWRITE(0);
        RESC(alB); __syncthreads();
        SBAR(); qkt(pA0, pA1, K_lds, qr, qp, r32, hi);
        finishSM(pB0, pB1, alB, l_reg, pa0, pa1, pa2, pa3); SBAR();
        if (j + 2 < TPS) { SLOAD(j + 2); SBAR(); }
        pv_d0<1>(o, vb0, pa0, pa1, pa2, pa3); partialSM(pA0, pA1, m_reg, msub, alA, Wrow[j + 1], hi);
        __syncthreads(); if (j + 2 < TPS) { asm volatile("s_waitcnt vmcnt(0)" ::: "memory"); SWRITE(1); }
        RESC(alA); __syncthreads();
    }
    SBAR(); qkt(pB0, pB1, K_lds + SHM_K, qr, qp, r32, hi);
    finishSM(pA0, pA1, alA, l_reg, pa0, pa1, pa2, pa3); SBAR();
    pv_d0<0>(o, vb0, pa0, pa1, pa2, pa3); partialSM(pB0, pB1, m_reg, msub, alB, Wrow[TPS - 1], hi);
    __syncthreads(); RESC(alB);
    finishSM(pB0, pB1, alB, l_reg, pa0, pa1, pa2, pa3); SBAR();
    pv_d0<1>(o, vb0, pa0, pa1, pa2, pa3);
#undef SLOAD
#undef SWRITE
#undef RESC
    if (hi == 0) li_l[r32] = l_reg; asm volatile("s_waitcnt lgkmcnt(0)" ::: "memory");
    {
        bf16* ybase = C.Y + (size_t)(it.m0 + 32 * (wid & 1)) * DM + head * 128 + r32;
        unsigned short gq[16][4];
#pragma unroll
        for (int r = 0; r < 16; ++r)
#pragma unroll
            for (int d0 = 0; d0 < 4; ++d0) gq[r][d0] = ybase[(size_t)crow(r, hi) * DM + d0 * 32];
        asm volatile("" ::: "memory");
#pragma unroll
        for (int r = 0; r < 16; ++r) { const float l = li_l[crow(r, hi)]; const float rl = l > 0.f ? __builtin_amdgcn_rcpf(l) : 0.f;
#pragma unroll
            for (int d0 = 0; d0 < 4; ++d0) { if (store) ybase[(size_t)crow(r, hi) * DM + d0 * 32] = (bf16)(cvt_pk_bf16(o[d0][r] * rl * bf2f(gq[r][d0]), 0.f) & 0xffffu); } }
    }
}
__device__ __forceinline__ void attn_item(char* shm, const AttnItem& it, const P2Ctx& C, int tid, int wid, int lane) {
    LAS unsigned long long* Wl = (LAS unsigned long long*)(shm + ATT_W);
    if (it.nt > 4) {
      for (int rep = 0; rep < ((P2REP & 1) ? 2 : 1); ++rep) {
        if constexpr (P2PARTS & 1) for (int r1 = 0; r1 < ((P2REP & 8) ? 2 : 1); ++r1) a1_scores(shm, it, C, tid, wid, lane);
        if constexpr (P2PARTS & 2) for (int r2 = 0; r2 < ((P2REP & 16) ? 2 : 1); ++r2) for (int qi = 0; qi < 8; ++qi) { asm volatile("" : "+v"(lane)); const int q = wid + 8 * qi; const unsigned short* srow = C.S + (size_t)q * SLD; LAS unsigned long long* Wq = Wl + q * MW;
            if (it.nt <= 16) a2_select<8>(srow, it.nt, Wq, lane); else if (it.nt <= 32) a2_select<16>(srow, it.nt, Wq, lane); else if (it.nt <= 48) a2_select<24>(srow, it.nt, Wq, lane); else a2_select<33>(srow, it.nt, Wq, lane); }
        __syncthreads(); }
    } else { for (int i = tid; i < 64 * it.nt; i += NWAVES * 64) Wl[(i / it.nt) * MW + (i % it.nt)] = ~0ull; }
    if (it.ntp > it.nt && tid < 64) Wl[tid * MW + it.nt] = (unsigned long long)(unsigned)(lane >> 8);
    __syncthreads();
    if constexpr (P2PARTS & 4) for (int rep = 0; rep < ((P2REP & 2) ? 2 : 1); ++rep) { const bool st = rep == ((P2REP & 2) ? 1 : 0) || !C.rt_true;
    attn_head(shm, it, C, 0, tid, wid, lane, st); __syncthreads();
    attn_head(shm, it, C, 1, tid, wid, lane, st); __syncthreads(); }
}

constexpr int CP_P = 64 * 1040;
constexpr int DPITCH = 1040;
__device__ __forceinline__ void ld_row8(const bf16* p, float (&v)[8]) { unpack8(*(const GAS v4u*)p, v); }
__device__ __forceinline__ void ld_row8(const float* p, float (&v)[8]) { const f32x4 a = *(const GAS f32x4*)p, b = *(const GAS f32x4*)(p + 4); v[0] = a[0]; v[1] = a[1]; v[2] = a[2]; v[3] = a[3]; v[4] = b[0]; v[5] = b[1]; v[6] = b[2]; v[7] = b[3]; }
__device__ __forceinline__ void cp_item(char* shm, int tile, const P2Ctx& C, int tid, int wid, int lane, bool store) {
    asm volatile("" : "+v"(tid)); lane = tid & 63; wid = __builtin_amdgcn_readfirstlane(tid >> 6);
    const int m0 = tile * 64; const bool smp = m0 >= MP; const int b = smp ? (m0 - MP) >> 6 : m0 >> 12, t0 = smp ? 0 : (m0 & (SEQ - 1)), mb = m0 - t0;
    const int c0 = (tid & 63) * 8, r0 = (tid >> 6) * 8;
    {
        float w0[8], w1[8], w2[8], bias[8]; ld_row8(C.conv_w + c0, w0); ld_row8(C.conv_w + 512 + c0, w1); ld_row8(C.conv_w + 1024 + c0, w2); ld_row8(C.conv_b + c0, bias);
        float xm2[8], xm1[8], x0[8];
#define LDX(tt_, v_) do { const int tt__ = (tt_); if (tt__ >= 0) ld_row8(C.CIN + (size_t)(mb + tt__) * 512 + c0, v_); \
            else if (smp) ld_row8(C.state_conv + ((size_t)b * 2 + (2 + tt__)) * 512 + c0, v_); \
            else { _Pragma("unroll") for (int i_ = 0; i_ < 8; ++i_) v_[i_] = 0.f; } } while (0)
        LDX(t0 + r0 - 2, xm2); LDX(t0 + r0 - 1, xm1);
#pragma unroll
        for (int r = 0; r < 8; ++r) {
            const int t = t0 + r0 + r; LDX(t, x0);
            bf16* yp = C.Y + (size_t)(mb + t) * DM + 1024 + c0; float g[8], y[8]; ld_row8(yp, g);
#pragma unroll
            for (int i = 0; i < 8; ++i) { y[i] = g[i] * (xm2[i] * w0[i] + xm1[i] * w1[i] + x0[i] * w2[i] + bias[i]); xm2[i] = xm1[i]; xm1[i] = x0[i]; }
            if (store) *(GAS v4u*)yp = pack8(y);
        }
#undef LDX
    }
    {
        char* P = shm + CP_P;
        for (int idx = tid; idx < 79 * 64; idx += NWAVES * 64) {
            const int row = idx >> 6, ch = idx & 63, tt = t0 - 15 + row; v4u v = {0u, 0u, 0u, 0u};
            if (tt >= 0) v = *(const GAS v4u*)(C.PIN + (size_t)(mb + tt) * 512 + ch * 8);
            else if (smp) { float h[8]; ld_row8(C.state_pool + ((size_t)b * 15 + (15 + tt)) * 512 + ch * 8, h); v = pack8(h); }
            *(v4u*)(P + row * DPITCH + ch * 16) = v;
        }
        __syncthreads();
        const int wl = 2 << (c0 >> 7);
        const char* Pc = P + c0 * 2;
        float s[8];
#pragma unroll
        for (int i = 0; i < 8; ++i) s[i] = 0.f;
#pragma unroll 1
        for (int j = 1; j < 16; ++j) if (j < wl) { float v[8]; unpack8(*(const v4u*)(Pc + (15 + r0 - j) * DPITCH), v);
#pragma unroll
            for (int i = 0; i < 8; ++i) s[i] += v[i]; }
#pragma unroll 1
        for (int r = 0; r < 8; ++r) {
            const int t = t0 + r0 + r; float pt[8], po[8];
            unpack8(*(const v4u*)(Pc + (15 + r0 + r) * DPITCH), pt);
#pragma unroll
            for (int i = 0; i < 8; ++i) s[i] += pt[i];
            const int cnt = smp ? wl : (t + 1 < wl ? t + 1 : wl); const float rc = 1.0f / (float)cnt;
            float d[8];
#pragma unroll
            for (int i = 0; i < 8; ++i) d[i] = s[i] * rc - pt[i];
            *(v4u*)(shm + (r0 + r) * DPITCH + c0 * 2) = pack8(d);
            unpack8(*(const v4u*)(Pc + (15 + r0 + r - (wl - 1)) * DPITCH), po);
#pragma unroll
            for (int i = 0; i < 8; ++i) s[i] -= po[i];
        }
    }
    __syncthreads();
    {
        const int g = wid >> 1, rh = wid & 1, fr = lane & 15, fq = lane >> 4;
        f32x4 acc[2][8];
#pragma unroll
        for (int mt = 0; mt < 2; ++mt)
#pragma unroll
            for (int nt = 0; nt < 8; ++nt) acc[mt][nt] = (f32x4){0.f, 0.f, 0.f, 0.f};
        bf16x8 af[2][4];
#pragma unroll
        for (int mt = 0; mt < 2; ++mt)
#pragma unroll
            for (int ks = 0; ks < 4; ++ks) af[mt][ks] = *reinterpret_cast<const bf16x8*>(shm + (32 * rh + 16 * mt + fr) * DPITCH + (g * 128 + 32 * ks + 8 * fq) * 2);
#pragma unroll
        for (int nt = 0; nt < 8; ++nt) {
            const bf16* wp = C.PWt + ((size_t)(g * 128 + 16 * nt + fr)) * 128 + 8 * fq;
#pragma unroll
            for (int ks = 0; ks < 4; ++ks) { const bf16x8 bw = ld8(wp + 32 * ks);
#pragma unroll
                for (int mt = 0; mt < 2; ++mt) acc[mt][nt] = __builtin_amdgcn_mfma_f32_16x16x32_bf16(bw, af[mt][ks], acc[mt][nt], 0, 0, 0); }
        }
#pragma unroll
        for (int mt = 0; mt < 2; ++mt)
#pragma unroll
            for (int nt = 0; nt < 8; ++nt) {
                const int row = m0 + 32 * rh + 16 * mt + fr, col = g * 128 + 16 * nt + 4 * fq;
                const f32x4 sc = *(const GAS f32x4*)(C.pool_scale + col); bf16* yp = C.Y + (size_t)row * DM + 1536 + col;
                const v2u gw = *(const GAS v2u*)yp; const f32x4 a = acc[mt][nt];
                v2u o; o.x = cvt_pk_bf16(a[0] * sc[0] * bflo(gw.x), a[1] * sc[1] * bfhi(gw.x)); o.y = cvt_pk_bf16(a[2] * sc[2] * bflo(gw.y), a[3] * sc[3] * bfhi(gw.y));
                if (store) *(GAS v2u*)yp = o;
            }
    }
    __syncthreads();
}
__device__ __forceinline__ void p2_phase(const Frame& F, char* shm, const P2Ctx& C, unsigned* qhead) {
    int tid = F.tid; asm volatile("" : "+v"(tid));
    const int lane = tid & 63, wave = __builtin_amdgcn_readfirstlane(tid >> 6);
    for (;;) {
        if (tid == 0) F.MISC[0] = __hip_atomic_fetch_add(qhead, 1u, __ATOMIC_RELAXED, __HIP_MEMORY_SCOPE_AGENT);
        __syncthreads();
        const int item = (int)F.MISC[0];
        __syncthreads();
        if (item >= N_ITEMS) break;
        if (item < N_ATT_ITEMS) {
            AttnItem it;
            if (item < 16) { it.smp = 1; it.b = item; it.m0 = MP + 64 * item; it.nt = 65; }
            else { const int idx = item - 16, c = 63 - (idx >> 3); it.smp = 0; it.b = idx & 7; it.m0 = it.b * SEQ + 64 * c; it.nt = c + 1; }
            it.ntp = (it.nt + 1) & ~1;
            attn_item(shm, it, C, tid, wave, lane);
        } else if constexpr (P2PARTS & 8) for (int rep = 0; rep < ((P2REP & 4) ? 2 : 1); ++rep) cp_item(shm, item - N_ATT_ITEMS, C, tid, wave, lane, rep == ((P2REP & 4) ? 1 : 0) || !C.rt_true);
    }
}

#ifndef REP_MASK
#define REP_MASK 0
#endif
#define REPS(k, cond) (((REP_MASK >> (k)) & 1) && (cond) ? 2 : 1)
__global__ void __launch_bounds__(NWAVES * 64, 2) fwd_kernel(Args A) {
    extern __shared__ __attribute__((aligned(16))) unsigned char lds[];
    Frame F;
    F.lds = (LAS unsigned char*)lds; F.MISC = (volatile LAS unsigned*)(F.lds + MISC_OFF);
    F.tid = threadIdx.x; F.lane = F.tid & 63; F.wave = __builtin_amdgcn_readfirstlane(F.tid >> 6);
    F.G = gridDim.x; { const int bx = blockIdx.x; F.vcu = (F.G % 8 == 0) ? (bx % 8) * (F.G / 8) + bx / 8 : bx; }
    unsigned char* ws = A.ws; F.ctl = (unsigned*)(ws + WS_CTL);
    for (int u = F.tid; u < (LDS_BYTES - LDSCTL_OFF) / 4; u += NWAVES * 64) ((LAS unsigned*)(F.lds + LDSCTL_OFF))[u] = 0u;
    __syncthreads();
    XcdBarrier bar = xcd_barrier_post(F.ctl + CW_BAR, F.MISC + 8);
    float* const XR = A.out + O_Y;
    bf16* const H = (bf16*)(ws + WS_H); bf16* const Y = (bf16*)(ws + WS_Y); u8* const G = (u8*)(ws + WS_G); bf16* const Z = H;
#pragma unroll 1
    for (int l = 0; l < 2; ++l) {
        const float* xp = l == 0 ? A.x_prompt : XR; const float* xs = l == 0 ? A.x_sample : XR + (size_t)MP * DM;
        p0_prologue(F, A, l, xp, xs);
        xcd_barrier(bar);
#pragma unroll 1
        for (int rep = 0; rep < REPS(1, true); ++rep) {
            pg8::Gemm g{H, (const bf16*)(ws + WS_W1A), M, N1A, DM, DM, DM}; pg8::StaticOrder S; S.init(M, N1A, F.G, (int)blockIdx.x);
            EpiP1 E; E.Qb = (bf16*)(ws + WS_Q); E.Kb = (bf16*)(ws + WS_K); E.Vb = (bf16*)(ws + WS_V); E.IQb = (bf16*)(ws + WS_IQ); E.IKb = (bf16*)(ws + WS_IK); E.Y = Y; E.CIN = (bf16*)(ws + WS_CIN); E.PIN = (bf16*)(ws + WS_PIN); E.IW = (float*)(ws + WS_IW);
            E.k_p = A.out + O_KP + (size_t)l * MP * 256; E.k_s = A.out + O_KS + (size_t)l * MS * 256; E.v_p = A.out + O_VP + (size_t)l * MP * 256; E.v_s = A.out + O_VS + (size_t)l * MS * 256;
            E.ik_p = A.out + O_IKP + (size_t)l * MP * 64; E.ik_s = A.out + O_IKS + (size_t)l * MS * 64; E.cv_p = A.out + O_CP + (size_t)l * 8 * 2 * 512; E.cv_s = A.out + O_CS + (size_t)l * 16 * 2 * 512;
            E.pl_p = A.out + O_PP + (size_t)l * 8 * 15 * 512; E.pl_s = A.out + O_PS + (size_t)l * 16 * 15 * 512;
            pg8::gemm_phase<EpiP1, pg8::StaticOrder, true, true>(F.lds, g, S, E);
        }
#pragma unroll 1
        for (int rep = 0; rep < REPS(3, true); ++rep) {
            const int c = (int)((blockIdx.x + 20u) % (unsigned)F.G);
              pg8::Gemm g{(const bf16*)(ws + WS_H8), (const bf16*)(ws + WS_W8), M, N1B, DM / 2, DM / 2, DM / 2}; pg8::StaticOrder S; S.init(M, N1B, F.G, F.G == 256 ? c : (int)blockIdx.x);
            EpiP3 E; E.G = G;
            pg8::gemm_phase<EpiP3, pg8::StaticOrder, true, true>(F.lds, g, S, E);
        }
        xcd_barrier(bar);
        {
            P2Ctx C; C.Qb = (const bf16*)(ws + WS_Q); C.Kb = (const bf16*)(ws + WS_K); C.Vb = (const bf16*)(ws + WS_V); C.IQb = (const bf16*)(ws + WS_IQ); C.IKb = (const bf16*)(ws + WS_IK);
            C.CKb = (const bf16*)(ws + WS_CK); C.CVb = (const bf16*)(ws + WS_CV); C.CIKb = (const bf16*)(ws + WS_CIK); C.CIN = (const bf16*)(ws + WS_CIN); C.PIN = (const bf16*)(ws + WS_PIN); C.PWt = (const bf16*)(ws + WS_PW);
            C.IW = (const float*)(ws + WS_IW); C.Y = Y;
            C.state_conv = A.state_conv + (size_t)l * 16 * 2 * 512; C.state_pool = A.state_pool + (size_t)l * 16 * 15 * 512; C.conv_w = A.conv_w + (size_t)l * 3 * 512; C.conv_b = A.conv_b + (size_t)l * 512; C.pool_scale = A.pool_scale + (size_t)l * 512;
            C.S = (unsigned short*)(ws + WS_S + (size_t)blockIdx.x * S_WG_BYTES); C.rt_true = F.ctl[3000] == 0u;
            p2_phase(F, (char*)lds, C, F.ctl + CW_QUEUE + 64 * l);
        }
        xcd_barrier(bar);
#pragma unroll 1
        for (int rep = 0; rep < REPS(4, true); ++rep) {
            pg8::Gemm g{Y, (const bf16*)(ws + WS_WL), M, DM, 512, DM, DM}; pg8::SegOrder<4, 512> S; S.init(M, DM, F.G, (int)blockIdx.x);
            EpiP4 E; E.G = G; E.Z = Z;
            pg8::gemm_phase<EpiP4, pg8::SegOrder<4, 512>, true, true>(F.lds, g, S, E);
            xcd_barrier(bar);
        }
#pragma unroll 1
        for (int rep = 0; rep < REPS(5, l == 0); ++rep) {
            pg8::Gemm g{Z, (const bf16*)(ws + WS_WO), M, DM, DM, DM, DM}; pg8::StaticOrder S; S.init(M, DM, F.G, (int)blockIdx.x);
            EpiP5 E; E.xp = xp; E.xs = xs; E.out = XR;
            pg8::gemm_phase<EpiP5, pg8::StaticOrder, true, true>(F.lds, g, S, E);
            xcd_barrier(bar);
        }
    }
    { int tid = F.tid; asm volatile("" : "+v"(tid)); const int lane = tid & 63, wave = __builtin_amdgcn_readfirstlane(tid >> 6);
      const int gw = F.vcu * NWAVES + wave, NGW = F.G * NWAVES;
      for (int m = gw; m < M; m += NGW) rmsnorm_row<false>(XR + (size_t)m * DM, A.final_g, XR + (size_t)m * DM, lane); }
}

extern "C" void kernel_launch(void* const* d_in, const int* in_sizes, int n_in, void* d_out, int out_size, void* d_ws, size_t ws_size, hipStream_t stream) {
    static int grid = 0;
    if (grid == 0) {
        if (n_in != 18 || in_sizes[0] != MP * DM || ws_size < WS_END) { fprintf(stderr, "kernel_launch: unexpected shapes (n_in %d, in0 %d, out %d, ws %zu; need ws >= %zu); nothing launched\n", n_in, n_in > 0 ? in_sizes[0] : -1, out_size, ws_size, (size_t)WS_END); grid = -1; return; }
        int dev = 0, cus = 0, per_cu = 0;
        if (hipGetDevice(&dev) != hipSuccess || hipDeviceGetAttribute(&cus, hipDeviceAttributeMultiprocessorCount, dev) != hipSuccess) { fprintf(stderr, "kernel_launch: device query failed\n"); grid = -1; return; }
        if (hipFuncSetAttribute((const void*)fwd_kernel, hipFuncAttributeMaxDynamicSharedMemorySize, LDS_BYTES) != hipSuccess) { fprintf(stderr, "kernel_launch: hipFuncSetAttribute failed\n"); grid = -1; return; }
        if (hipOccupancyMaxActiveBlocksPerMultiprocessor(&per_cu, (const void*)fwd_kernel, NWAVES * 64, LDS_BYTES) != hipSuccess || per_cu < 1) { fprintf(stderr, "kernel_launch: occupancy query reports %d workgroups per CU\n", per_cu); }
        (void)hipGetLastError();
        grid = cus > 256 ? 256 : cus;
    }
    if (grid < 0) return;
    if (hipMemsetAsync((char*)d_ws + WS_CTL, 0, CTL_ZERO_BYTES, stream) != hipSuccess) { fprintf(stderr, "kernel_launch: memset failed\n"); return; }
    Args a{};
    a.x_prompt = (const float*)d_in[0]; a.x_sample = (const float*)d_in[1]; a.cache_k = (const float*)d_in[2]; a.cache_v = (const float*)d_in[3]; a.cache_ik = (const float*)d_in[4];
    a.state_conv = (const float*)d_in[5]; a.state_pool = (const float*)d_in[6]; a.norm_g = (const float*)d_in[7]; a.w_in = (const float*)d_in[8]; a.conv_w = (const float*)d_in[9]; a.conv_b = (const float*)d_in[10];
    a.pool_w = (const float*)d_in[11]; a.pool_scale = (const float*)d_in[12]; a.lift_a = (const float*)d_in[13]; a.lift_b = (const float*)d_in[14]; a.lift_c = (const float*)d_in[15]; a.w_out = (const float*)d_in[16]; a.final_g = (const float*)d_in[17];
    a.out = (float*)d_out; a.ws = (unsigned char*)d_ws;
    hipLaunchKernelGGL(fwd_kernel, dim3(grid), dim3(NWAVES * 64), LDS_BYTES, stream, a);
    const hipError_t le = hipPeekAtLastError();
    if (le != hipSuccess) fprintf(stderr, "kernel_launch: launch failed: %s\n", hipGetErrorName(le));
}
```

```cpp
#include <hip/hip_runtime.h>
#include <cstdio>
#include <cstdint>

namespace pg8 {
#define PG8_LAS __attribute__((address_space(3)))
typedef unsigned short bf16_t;
typedef short bf16x8 __attribute__((ext_vector_type(8)));
typedef float f32x4 __attribute__((ext_vector_type(4)));
typedef unsigned u32x4 __attribute__((ext_vector_type(4)));
constexpr int BM = 256, BK = 64, HALF = 128, HTB = HALF * BK * 2  , STAGE_BYTES = 8 * HTB, NXCD = 8, WGM = 8;

__host__ __device__ __forceinline__ int lds_byte(int r, int c) { const int st = (r >> 4) * 2 + (c >> 5), rr = r & 15, cc = c & 31, ob = rr * 64 + cc * 2; return st * 1024 + (ob ^ (((ob >> 9) & 1) << 5)); }
__host__ __device__ __forceinline__ void stage_rc(int b, int& R, int& C) { const int st = b / 1024, sb = b % 1024, swz = sb ^ (((sb >> 9) & 1) << 5); R = (st >> 1) * 16 + swz / 64; C = (st & 1) * 32 + (swz % 64) / 2; }
__host__ __device__ __forceinline__ int perm32(int rho) { const int n = rho >> 4, i = rho & 15; return 8 * (i >> 2) + 4 * n + (i & 3); }

struct Unit { int pm, pn, koff, seg; };
struct Gemm { const bf16_t* A; const bf16_t* Bt; int M, N, K, lda, ldb; };

struct StaticOrder {
    int nM, nN, nwg, G, c;
    __host__ __device__ void init(int M, int N, int G_, int c_) { nM = M / BM; nN = N / BM; nwg = nM * nN; G = G_; c = c_; }
    __host__ __device__ bool next(int i, Unit& u) const {
        const long L = (long)i * G + c; if (L >= nwg) return false;
        int wgid = (int)L; { const int q = nwg / NXCD, r = nwg % NXCD, xcd = wgid % NXCD, off = wgid / NXCD; wgid = (xcd < r ? xcd * (q + 1) : r * (q + 1) + (xcd - r) * q) + off; }
        const int nig = WGM * nN, gid = wgid / nig, fm = gid * WGM, gsz = (nM - fm) < WGM ? (nM - fm) : WGM;
        u.pm = fm + ((wgid % nig) % gsz); u.pn = (wgid % nig) / gsz; u.koff = 0; u.seg = 0; return true;
    }
    __device__ __forceinline__ void a_ready(const Unit&) const {}
    __device__ __forceinline__ void done(const Unit&) const {}
};
template <int NSEG, int KS> struct SegOrder : StaticOrder {
    __host__ __device__ bool next(int i, Unit& u) const { if (!StaticOrder::next(i / NSEG, u)) return false; u.seg = i % NSEG; u.koff = u.seg * KS; return true; }
};
typedef int i32x8 __attribute__((ext_vector_type(8)));
typedef int i32x4 __attribute__((ext_vector_type(4)));
__device__ __forceinline__ i32x8 cat8(bf16x8 a, bf16x8 b) { const i32x4 x = __builtin_bit_cast(i32x4, a), y = __builtin_bit_cast(i32x4, b); return __builtin_shufflevector(x, y, 0, 1, 2, 3, 4, 5, 6, 7); }
__device__ __forceinline__ unsigned cvt_pk_bf16(float lo, float hi) { typedef float f2_ __attribute__((ext_vector_type(2))); typedef __bf16 b2_ __attribute__((ext_vector_type(2))); const b2_ r = __builtin_convertvector((f2_){lo, hi}, b2_); return __builtin_bit_cast(unsigned, r); }

template <class Epi, class Sched, bool ALIGN_EPI = false, bool SP2 = false>
__device__ __forceinline__ void gemm_phase(PG8_LAS unsigned char* lds, const Gemm g, const Sched& S, const Epi& E) {
    int tid_ = threadIdx.x; asm volatile("" : "+v"(tid_));
    const int tid = tid_, wid = __builtin_amdgcn_readfirstlane(tid >> 6), lane = tid & 63, wr = wid >> 2, wc = wid & 3, fr = lane & 15, fq = lane >> 4;
    const int K = g.K, nt = K / BK;
    unsigned voffA[2], voffB[2];
#pragma unroll
    for (int i = 0; i < 2; ++i) { int R, C; stage_rc(tid * 16 + i * 8192, R, C); const int Rb = Epi::PERM ? ((R & ~31) + perm32(R & 31)) : R;
        voffA[i] = (unsigned)(R * g.lda + C) * 2u; voffB[i] = (unsigned)(Rb * g.ldb + C) * 2u; }
    const size_t kstep = (size_t)(BK * 2);
    const size_t hstepA = (size_t)HALF * g.lda * 2, hstepB = (size_t)HALF * g.ldb * 2;
    const size_t tstepA = 2 * hstepA, tstepB = 2 * hstepB;
    const unsigned ldsw = (unsigned)wid * 1024u;
    const int aoff = lds_byte(wr * 64 + fr, fq * 8), boff = lds_byte(wc * 32 + fr, fq * 8);
#define PG8_SA(b, h) (((b) * 2 + (h)) * HTB)
#define PG8_SB(b, h) ((4 + (b) * 2 + (h)) * HTB)
#define PG8_STAGE(bufoff, gbase, voff) do { _Pragma("unroll") for (int _i = 0; _i < 2; ++_i) \
        __builtin_amdgcn_global_load_lds((const unsigned*)((const char*)(gbase) + (voff)[_i]), (PG8_LAS unsigned*)(lds + (bufoff) + ldsw + _i * 8192), 16, 0, 0); } while (0)
#define PG8_RD(off_) (*(const PG8_LAS i32x4*)(lds + (off_)))
#define PG8_LDA(dst, b, h) do { _Pragma("unroll") for (int m = 0; m < 4; ++m) dst[m] = __builtin_shufflevector(PG8_RD(PG8_SA(b, h) + aoff + m * 2048), PG8_RD(PG8_SA(b, h) + aoff + m * 2048 + 1024), 0, 1, 2, 3, 4, 5, 6, 7); } while (0)
#define PG8_LDB(dst, b, h) do { _Pragma("unroll") for (int n = 0; n < 2; ++n) dst[n] = __builtin_shufflevector(PG8_RD(PG8_SB(b, h) + boff + n * 2048), PG8_RD(PG8_SB(b, h) + boff + n * 2048 + 1024), 0, 1, 2, 3, 4, 5, 6, 7); } while (0)
#define PG8_LO(v_) __builtin_bit_cast(bf16x8, __builtin_shufflevector(v_, v_, 0, 1, 2, 3))
#define PG8_HI(v_) __builtin_bit_cast(bf16x8, __builtin_shufflevector(v_, v_, 4, 5, 6, 7))
#define PG8_MMA(ai, bj, At, Bt) do { __builtin_amdgcn_s_setprio(1); if constexpr (Epi::FP8) { \
          \
        _Pragma("unroll") for (int m = 0; m < 4; ++m) _Pragma("unroll") for (int n = 0; n < 2; ++n) \
        asm volatile("v_mfma_scale_f32_16x16x128_f8f6f4 %0, %1, %2, %0, %3, %3 op_sel_hi:[0,0,0]" : "+v"(acc[ai][bj][m][n]) : "v"(Bt[n]), "v"(At[m]), "v"(mx_one));   \
    } else { _Pragma("unroll") for (int m = 0; m < 4; ++m) _Pragma("unroll") for (int n = 0; n < 2; ++n) { \
        acc[ai][bj][m][n] = __builtin_amdgcn_mfma_f32_16x16x32_bf16(PG8_LO(Bt[n]), PG8_LO(At[m]), acc[ai][bj][m][n], 0, 0, 0); \
        acc[ai][bj][m][n] = __builtin_amdgcn_mfma_f32_16x16x32_bf16(PG8_HI(Bt[n]), PG8_HI(At[m]), acc[ai][bj][m][n], 0, 0, 0); } } __builtin_amdgcn_s_setprio(0); } while (0)
#define PG8_WAIT_V(n) asm volatile("s_waitcnt vmcnt(" #n ")" ::: "memory")
#define PG8_WAIT_L(n) asm volatile("s_waitcnt lgkmcnt(" #n ")" ::: "memory")
#define PG8_BAR __builtin_amdgcn_s_barrier()
#define PG8_SCHED __builtin_amdgcn_sched_barrier(0)
    Unit cur, nxt; int ui = 0;
    if (!S.next(0, cur)) return;
    f32x4 acc[2][2][4][2];
#pragma unroll
    for (int a = 0; a < 2; ++a)
#pragma unroll
        for (int b = 0; b < 2; ++b)
#pragma unroll
            for (int m = 0; m < 4; ++m)
#pragma unroll
                for (int n = 0; n < 2; ++n) acc[a][b][m][n] = (f32x4){0.f, 0.f, 0.f, 0.f};
    i32x8 At[4], B0[2], B1[2];
    int mx_one = 0x7f7f7f7f; asm volatile("" : "+v"(mx_one));
    const char* cA = (const char*)g.A + (size_t)cur.pm * tstepA + (size_t)cur.koff * 2; const char* cB = (const char*)g.Bt + (size_t)cur.pn * tstepB + (size_t)cur.koff * 2;
    S.a_ready(cur);
    if constexpr (SP2) {
        PG8_STAGE(PG8_SB(0, 0), cB, voffB); PG8_STAGE(PG8_SB(0, 1), cB + hstepB, voffB); PG8_STAGE(PG8_SA(0, 0), cA, voffA); PG8_STAGE(PG8_SA(0, 1), cA + hstepA, voffA);
        if (wr == 1) PG8_BAR;
        PG8_WAIT_V(2); PG8_BAR;
        PG8_STAGE(PG8_SB(1, 0), cB + kstep, voffB); PG8_STAGE(PG8_SA(1, 0), cA + kstep, voffA); PG8_STAGE(PG8_SB(1, 1), cB + hstepB + kstep, voffB);
        PG8_WAIT_V(6); PG8_BAR;
    } else {
        PG8_STAGE(PG8_SB(0, 0), cB, voffB); PG8_STAGE(PG8_SA(0, 0), cA, voffA); PG8_STAGE(PG8_SB(0, 1), cB + hstepB, voffB); PG8_STAGE(PG8_SA(0, 1), cA + hstepA, voffA);
        if (wr == 1) PG8_BAR;
        PG8_WAIT_V(4); PG8_BAR;
        PG8_STAGE(PG8_SB(1, 0), cB + kstep, voffB); PG8_STAGE(PG8_SA(1, 0), cA + kstep, voffA); PG8_STAGE(PG8_SB(1, 1), cB + hstepB + kstep, voffB);
        PG8_WAIT_V(6); PG8_BAR;
    }
    for (;;) {
        const bool has_next = S.next(ui + 1, nxt);
        const char* nA = has_next ? (const char*)g.A + (size_t)nxt.pm * tstepA + (size_t)nxt.koff * 2 : cA; const char* nB = has_next ? (const char*)g.Bt + (size_t)nxt.pn * tstepB + (size_t)nxt.koff * 2 : cB;
        for (int t = 0; t < nt; t += 2) {
            const bool last = (t == nt - 2);
            const char* a1 = cA + (size_t)(t + 1) * kstep;
            const char* a2 = last ? nA : cA + (size_t)(t + 2) * kstep; const char* b2 = last ? nB : cB + (size_t)(t + 2) * kstep;
            const char* a3 = a2 + kstep; const char* b3 = b2 + kstep;
            if (last && has_next) S.a_ready(nxt);
            if constexpr (SP2) {
            PG8_LDB(B0, 0, 0); PG8_LDB(B1, 0, 1); PG8_SCHED; PG8_LDA(At, 0, 0); PG8_STAGE(PG8_SA(1, 1), a1 + hstepA, voffA);
            PG8_WAIT_V(8); PG8_WAIT_L(0); PG8_BAR; PG8_MMA(0, 0, At, B0); PG8_MMA(0, 1, At, B1); PG8_BAR; PG8_SCHED;
            PG8_LDA(At, 0, 1); PG8_STAGE(PG8_SB(0, 0), b2, voffB); PG8_STAGE(PG8_SB(0, 1), b2 + hstepB, voffB); PG8_STAGE(PG8_SA(0, 0), a2, voffA);
            PG8_WAIT_V(8); PG8_WAIT_L(0); PG8_BAR; PG8_MMA(1, 0, At, B0); PG8_MMA(1, 1, At, B1); PG8_BAR; PG8_SCHED;
            PG8_LDB(B0, 1, 0); PG8_LDB(B1, 1, 1); PG8_SCHED; PG8_LDA(At, 1, 0); PG8_STAGE(PG8_SA(0, 1), a2 + hstepA, voffA);
            PG8_WAIT_V(8); PG8_WAIT_L(0); PG8_BAR; PG8_MMA(0, 0, At, B0); PG8_MMA(0, 1, At, B1); PG8_BAR; PG8_SCHED;
            PG8_LDA(At, 1, 1); PG8_STAGE(PG8_SB(1, 0), b3, voffB); PG8_STAGE(PG8_SB(1, 1), b3 + hstepB, voffB); PG8_STAGE(PG8_SA(1, 0), a3, voffA);
            PG8_WAIT_V(8); PG8_WAIT_L(0); PG8_BAR; PG8_MMA(1, 0, At, B0); PG8_MMA(1, 1, At, B1); PG8_BAR; PG8_SCHED;
            } else {
            PG8_LDB(B0, 0, 0); PG8_SCHED; PG8_LDA(At, 0, 0); PG8_STAGE(PG8_SA(1, 1), a1 + hstepA, voffA);
            PG8_WAIT_L(8); PG8_BAR; PG8_WAIT_L(0); PG8_MMA(0, 0, At, B0); PG8_BAR; PG8_SCHED;
            PG8_LDB(B1, 0, 1); PG8_STAGE(PG8_SB(0, 0), b2, voffB);
            PG8_BAR; PG8_WAIT_L(0); PG8_MMA(0, 1, At, B1); PG8_BAR;
            PG8_LDA(At, 0, 1); PG8_STAGE(PG8_SA(0, 0), a2, voffA);
            PG8_BAR; PG8_WAIT_L(0); PG8_MMA(1, 0, At, B0); PG8_BAR; PG8_SCHED;
            PG8_STAGE(PG8_SB(0, 1), b2 + hstepB, voffB);
            PG8_WAIT_V(6); PG8_BAR; PG8_MMA(1, 1, At, B1); PG8_BAR;
            PG8_LDB(B0, 1, 0); PG8_SCHED; PG8_LDA(At, 1, 0); PG8_STAGE(PG8_SA(0, 1), a2 + hstepA, voffA);
            PG8_WAIT_L(8); PG8_BAR; PG8_WAIT_L(0); PG8_MMA(0, 0, At, B0); PG8_BAR; PG8_SCHED;
            PG8_LDB(B1, 1, 1); PG8_STAGE(PG8_SB(1, 0), b3, voffB);
            PG8_BAR; PG8_WAIT_L(0); PG8_MMA(0, 1, At, B1); PG8_BAR;
            PG8_LDA(At, 1, 1); PG8_STAGE(PG8_SA(1, 0), a3, voffA);
            PG8_BAR; PG8_WAIT_L(0); PG8_MMA(1, 0, At, B0); PG8_BAR; PG8_SCHED;
            PG8_STAGE(PG8_SB(1, 1), b3 + hstepB, voffB);
            PG8_WAIT_V(6); PG8_BAR; PG8_MMA(1, 1, At, B1); PG8_BAR;
            }
        }
        if constexpr (ALIGN_EPI) { if (wr == 0) PG8_BAR; }
        if constexpr (Epi::FP8) asm volatile("s_nop 15\n\ts_nop 15" ::: "memory");
        if constexpr (!Epi::AFTER_DRAIN) { E(acc, cur, wr, wc, fr, fq); S.done(cur); }
        if (!has_next) break;
        if (cur.seg == Epi::NSEG - 1)
#pragma unroll
        for (int a = 0; a < 2; ++a)
#pragma unroll
            for (int b = 0; b < 2; ++b)
#pragma unroll
                for (int m = 0; m < 4; ++m)
#pragma unroll
                    for (int n = 0; n < 2; ++n) acc[a][b][m][n] = (f32x4){0.f, 0.f, 0.f, 0.f};
        cur = nxt; cA = nA; cB = nB; ++ui;
        if constexpr (ALIGN_EPI) { if (wr == 1) PG8_BAR; }
    }
    PG8_WAIT_V(0);
    if constexpr (!ALIGN_EPI) { if (wr == 0) PG8_BAR; }
    PG8_BAR;
    if constexpr (Epi::AFTER_DRAIN) { E.fused(acc, cur, wr, wc, fr, fq, lds, wid, lane); S.done(cur); }
#undef PG8_SA
#undef PG8_SB
#undef PG8_STAGE
#undef PG8_LDA
#undef PG8_RD
#undef PG8_LO
#undef PG8_HI
#undef PG8_LDB
#undef PG8_MMA
#undef PG8_WAIT_V
#undef PG8_WAIT_L
#undef PG8_BAR
#undef PG8_SCHED
}

}

constexpr int NWAVES = 8;
constexpr int DM = 2048, MP = 32768, MS = 1024, M = MP + MS;
constexpr int SEQ = 4096, PAST = 4096, DSEQ = 64, NB_P = 8, NB_S = 16;
constexpr int IN_W = 12880;
constexpr int N1A = 4864, N1B = 6144, N8 = 8192;
constexpr int C_Q = 0, C_K = 1024, C_V = 1280, C_IQ = 1536, C_IK = 2560, C_IW = 2624, C_GA = 2640, C_U = 3664, C_BGT = 4176, C_CG = 4688, C_GB = 5200, C_PIN = 5712, C_GC = 6224, C_MA = 6736;
constexpr float EPS = 1e-6f;
constexpr int SLD = 4224;
constexpr int MW = 66;
constexpr int N_ATT_ITEMS = 16 + 512, N_CP_ITEMS = M / 64, N_ITEMS = N_ATT_ITEMS + N_CP_ITEMS;

constexpr size_t MiB = 1u << 20;
constexpr size_t al256(size_t x) { return (x + 255) / 256 * 256; }
constexpr size_t WS_CTL = 0, CTL_ZERO_BYTES = 1 * MiB;
constexpr size_t WS_W1A = 1 * MiB;
constexpr size_t WS_W1B = WS_W1A + (size_t)N1A * DM * 2;
constexpr size_t WS_WL = WS_W1B + (size_t)N1B * DM * 2;
constexpr size_t WS_WO = WS_WL + (size_t)DM * DM * 2;
constexpr size_t WS_PW = WS_WO + (size_t)DM * DM * 2;
constexpr size_t WS_H = al256(WS_PW + 4 * 128 * 128 * 2);
constexpr size_t WS_Y = WS_H + (size_t)M * DM * 2;
constexpr size_t WS_Q = WS_Y + (size_t)M * DM * 2;
constexpr size_t WS_K = WS_Q + (size_t)M * 1024 * 2;
constexpr size_t WS_V = WS_K + (size_t)M * 256 * 2;
constexpr size_t WS_IQ = WS_V + (size_t)M * 256 * 2;
constexpr size_t WS_IK = WS_IQ + (size_t)M * 1024 * 2;
constexpr size_t WS_IW = WS_IK + (size_t)M * 64 * 2;
constexpr size_t WS_CIN = WS_IW + (size_t)M * 16 * 4;
constexpr size_t WS_PIN = WS_CIN + (size_t)M * 512 * 2;
constexpr size_t WS_CK = WS_PIN + (size_t)M * 512 * 2;
constexpr size_t WS_CV = WS_CK + (size_t)NB_S * PAST * 256 * 2;
constexpr size_t WS_CIK = WS_CV + (size_t)NB_S * PAST * 256 * 2;
constexpr size_t WS_G = WS_CIK + (size_t)NB_S * PAST * 64 * 2;
constexpr size_t WS_H8 = WS_G + (size_t)M * N1B;
constexpr size_t WS_W8 = WS_H8 + (size_t)M * DM;
constexpr size_t WS_END = WS_W8 + (size_t)N8 * DM;
constexpr size_t WS_S = WS_H;
constexpr size_t S_WG_BYTES = (size_t)64 * SLD * 2;
static_assert(256 * S_WG_BYTES <= (size_t)M * DM * 2, "score scratch fits the H region");
static_assert(WS_END <= (size_t)1024 * MiB, "workspace map must fit 1 GiB");
constexpr int CW_BAR = 4096;
constexpr int CW_QUEUE = 8192;

constexpr int RING_BYTES = 131072;
constexpr int LDS_BYTES = 155648;
constexpr int LDSCTL_OFF = LDS_BYTES - 1024, MISC_OFF = LDSCTL_OFF + 320;

#define GAS __attribute__((address_space(1)))
#define LAS __attribute__((address_space(3)))
typedef unsigned short bf16;
typedef unsigned v4u __attribute__((ext_vector_type(4)));
typedef unsigned v2u __attribute__((ext_vector_type(2)));
typedef float f32x4 __attribute__((ext_vector_type(4)));
typedef float f32x16 __attribute__((ext_vector_type(16)));
typedef short bf16x8 __attribute__((ext_vector_type(8)));
typedef short s16x4 __attribute__((ext_vector_type(4)));
#define LDS_WAIT() asm volatile("s_waitcnt lgkmcnt(0)" ::: "memory")
#define VM_WAIT() asm volatile("s_waitcnt vmcnt(0)" ::: "memory")
using pg8::cvt_pk_bf16;
__device__ __forceinline__ float bf2f(unsigned short b) { return __builtin_bit_cast(float, (unsigned)b << 16); }
__device__ __forceinline__ float bflo(unsigned w) { return __builtin_bit_cast(float, w << 16); }
__device__ __forceinline__ float bfhi(unsigned w) { return __builtin_bit_cast(float, w & 0xffff0000u); }
__device__ __forceinline__ v4u pack8(const float (&v)[8]) { v4u w; w.x = cvt_pk_bf16(v[0], v[1]); w.y = cvt_pk_bf16(v[2], v[3]); w.z = cvt_pk_bf16(v[4], v[5]); w.w = cvt_pk_bf16(v[6], v[7]); return w; }
__device__ __forceinline__ void unpack8(v4u w, float (&v)[8]) { v[0] = bflo(w.x); v[1] = bfhi(w.x); v[2] = bflo(w.y); v[3] = bfhi(w.y); v[4] = bflo(w.z); v[5] = bfhi(w.z); v[6] = bflo(w.w); v[7] = bfhi(w.w); }
__device__ __forceinline__ float sigmoidf_(float x) { return __builtin_amdgcn_rcpf(1.0f + __builtin_amdgcn_exp2f(-1.4426950408889634f * x)); }
__device__ __forceinline__ float siluf_(float x) { return x * sigmoidf_(x); }
#define dpp_f(v_, ctrl_) __builtin_bit_cast(float, __builtin_amdgcn_update_dpp(0, __builtin_bit_cast(int, (v_)), (ctrl_), 0xF, 0xF, true))
__device__ __forceinline__ float wave_sum(float v) {
    v += dpp_f(v, 0xB1); v += dpp_f(v, 0x4E); v += dpp_f(v, 0x141); v += dpp_f(v, 0x140);
    const int vi = __builtin_bit_cast(int, v);
    return (__builtin_bit_cast(float, __builtin_amdgcn_readlane(vi, 0)) + __builtin_bit_cast(float, __builtin_amdgcn_readlane(vi, 16))) + (__builtin_bit_cast(float, __builtin_amdgcn_readlane(vi, 32)) + __builtin_bit_cast(float, __builtin_amdgcn_readlane(vi, 48)));
}

#define XB_TMO      128
#define XB_XCNT(j)  (256  + 64 * (j))
#define XB_XSUB(j)  (1280 + 64 * (j))
#define XB_XGEN(j)  (2304 + 64 * (j))
#define XB_TOP      3328
#define XB_TOPGEN   3392
#define XCD_BAR_WORDS 3456
#define XB_SPIN_CAP (1u << 18)

__device__ __forceinline__ unsigned xb_ld(unsigned* p)              { return __hip_atomic_load(p, __ATOMIC_RELAXED, __HIP_MEMORY_SCOPE_AGENT); }
__device__ __forceinline__ unsigned xb_add(unsigned* p, unsigned v) { return __hip_atomic_fetch_add(p, v, __ATOMIC_RELAXED, __HIP_MEMORY_SCOPE_AGENT); }
__device__ __forceinline__ unsigned xb_xcc_id() { return (unsigned)__builtin_amdgcn_s_getreg((3 << 11) | 20) & 0xFu; }
#define XB_SPIN(cond, bar) do { unsigned _sp = 0; while (cond) { __builtin_amdgcn_s_sleep(1); \
    if ((++_sp & 255u) == 0u) { if (xb_ld(&(bar)[XB_TMO])) break; if (_sp > XB_SPIN_CAP) { atomicAdd(&(bar)[XB_TMO], 1u); break; } } } } while (0)

struct XcdBarrier {
    unsigned* bar; unsigned x;
    volatile LAS unsigned* st;
};

__device__ __forceinline__ XcdBarrier xcd_barrier_post(unsigned* bar, volatile LAS unsigned* st) {
    XcdBarrier b; b.bar = bar; b.x = xb_xcc_id(); b.st = st;
    if (threadIdx.x == 0) (void)xb_add(&bar[XB_XCNT(b.x)], 1u);
    return b;
}
__device__ __forceinline__ void xcd_barrier_complete(unsigned* bar, unsigned x, unsigned& nloc, unsigned& nx) {
    const unsigned G = gridDim.x * gridDim.y * gridDim.z;
    unsigned sum, cnt, mine, sp = 0u;
    for (;;) {
        sum = 0u; cnt = 0u; mine = 0u;
#pragma unroll
        for (unsigned j = 0; j < 16; ++j) { const unsigned c = xb_ld(&bar[XB_XCNT(j)]); sum += c; cnt += (c > 0u) ? 1u : 0u; mine = (j == x) ? c : mine; }
        if (sum == G) break;
        __builtin_amdgcn_s_sleep(1);
        if ((++sp & 255u) == 0u) { if (xb_ld(&bar[XB_TMO])) break; if (sp > XB_SPIN_CAP) { atomicAdd(&bar[XB_TMO], 1u); break; } }
    }
    nloc = mine > 0u ? mine : 1u; nx = cnt > 0u ? cnt : 1u;
}

__device__ __forceinline__ void xcd_barrier(const XcdBarrier& b) {
    asm volatile("s_waitcnt vmcnt(0)" ::: "memory");
    __syncthreads();
    if (threadIdx.x == 0) {
        unsigned* bar = b.bar;
        __builtin_amdgcn_s_waitcnt(0);
        unsigned nloc = b.st[0], nx = b.st[1];
        if (nloc == 0u) { xcd_barrier_complete(bar, b.x, nloc, nx); b.st[0] = nloc; b.st[1] = nx; }
        const unsigned old = xb_add(&bar[XB_XSUB(b.x)], 1u);
        const unsigned gen = old / nloc;
        if (old + 1u == (gen + 1u) * nloc) {
            __builtin_amdgcn_fence(__ATOMIC_RELEASE, "agent");
            asm volatile("s_waitcnt vmcnt(0)" ::: "memory");
            const unsigned og = xb_add(&bar[XB_TOP], 1u);
            const unsigned tg = og / nx;
            if (og + 1u == (tg + 1u) * nx) xb_add(&bar[XB_TOPGEN], 1u);
            else XB_SPIN(xb_ld(&bar[XB_TOPGEN]) == tg, bar);
            __builtin_amdgcn_fence(__ATOMIC_ACQUIRE, "agent");
            xb_add(&bar[XB_XGEN(b.x)], 1u);
            asm volatile("s_waitcnt vmcnt(0)" ::: "memory");
        } else {
            XB_SPIN(xb_ld(&bar[XB_XGEN(b.x)]) == gen, bar);
            __builtin_amdgcn_fence(__ATOMIC_ACQUIRE, "agent");
            asm volatile("s_waitcnt vmcnt(0)" ::: "memory");
        }
    }
    __syncthreads();
}


struct Args {
    const float* x_prompt; const float* x_sample; const float* cache_k; const float* cache_v; const float* cache_ik; const float* state_conv; const float* state_pool;
    const float* norm_g; const float* w_in; const float* conv_w; const float* conv_b; const float* pool_w; const float* pool_scale;
    const float* lift_a; const float* lift_b; const float* lift_c; const float* w_out; const float* final_g;
    float* out; unsigned char* ws;
};
struct Frame {
    LAS unsigned char* lds; volatile LAS unsigned* MISC; unsigned* ctl;
    int tid, lane, wave, vcu, G;
};
constexpr size_t O_Y = 0, O_KP = (size_t)M * DM, O_VP = O_KP + (size_t)2 * MP * 256, O_IKP = O_VP + (size_t)2 * MP * 256, O_CP = O_IKP + (size_t)2 * MP * 64, O_PP = O_CP + (size_t)2 * 8 * 2 * 512,
                 O_KS = O_PP + (size_t)2 * 8 * 15 * 512, O_VS = O_KS + (size_t)2 * MS * 256, O_IKS = O_VS + (size_t)2 * MS * 256, O_CS = O_IKS + (size_t)2 * MS * 64, O_PS = O_CS + (size_t)2 * 16 * 2 * 512, O_END = O_PS + (size_t)2 * 16 * 15 * 512;

__device__ const float c_inv[64] = { 1.0f, 0.8659643530845642f, 0.7498942017555237f, 0.6493816375732422f, 0.5623413324356079f, 0.486967533826828f, 0.4216965138912201f, 0.3651741147041321f, 0.3162277638912201f, 0.2738419771194458f, 0.23713737726211548f, 0.20535250008106232f, 0.17782793939113617f, 0.1539926528930664f, 0.1333521455526352f, 0.11547819525003433f, 0.10000000149011612f, 0.08659642934799194f, 0.0749894231557846f, 0.06493816524744034f, 0.05623413249850273f, 0.04869675263762474f, 0.04216964915394783f, 0.03651741147041321f, 0.03162277489900589f, 0.0273841954767704f, 0.023713737726211548f, 0.02053525112569332f, 0.017782794311642647f, 0.015399265103042126f, 0.013335213996469975f, 0.011547819711267948f, 0.009999999776482582f, 0.00865964312106371f, 0.007498942315578461f, 0.006493816152215004f, 0.005623413249850273f, 0.004869675263762474f, 0.0042169648222625256f, 0.0036517411936074495f, 0.003162277629598975f, 0.0027384196873754263f, 0.0023713738191872835f, 0.0020535250660032034f, 0.0017782794311642647f, 0.0015399265103042126f, 0.0013335214462131262f, 0.0011547820176929235f, 0.0010000000474974513f, 0.0008659643353894353f, 0.0007498941849917173f, 0.0006493816035799682f, 0.000562341301701963f, 0.0004869675321970135f, 0.0004216965171508491f, 0.00036517411353997886f, 0.0003162277571391314f, 0.00027384195709601045f, 0.00023713737027719617f, 0.00020535250951070338f, 0.00017782794020604342f, 0.0001539926597615704f, 0.0001333521504420787f, 0.00011547820031410083f };

__device__ __forceinline__ void sincos_rev(float ang, float& s, float& c) {
    float r = ang * 0.15915494309189535f; r = __builtin_amdgcn_fractf(r); s = __builtin_amdgcn_sinf(r); c = __builtin_amdgcn_cosf(r);
}

__device__ __forceinline__ int colmap_a(int np) {
    const int pn = np >> 8, jj = np & 255, half = jj >> 7, j = jj & 127;
    if (pn == 0) return C_K + (j >> 6) * 128 + (j & 63) + 64 * half;
    if (pn == 1) return C_V + jj;
    if (pn == 2) { if (j < 32) return C_IK + j + 32 * half; if (half == 0 && j < 48) return C_IW + (j - 32); return -1; }
    if (pn < 7)  return C_IQ + (4 * (pn - 3) + (j >> 5)) * 64 + (j & 31) + 32 * half;
    if (pn < 11) return (half ? C_CG : C_U) + (pn - 7) * 128 + j;
    if (pn < 15) return (half ? C_GB : C_BGT) + (pn - 11) * 128 + j;
    return (half ? C_GC : C_PIN) + (pn - 15) * 128 + j;
}
__device__ __forceinline__ int colmap_8(int np) {
    const int pn = np >> 8, jj = np & 255, half = jj >> 7, j = jj & 127;
    if (pn < 24) return C_MA + np;
    if (pn < 28) return C_Q + (2 * (pn - 24) + (j >> 6)) * 128 + (j & 63) + 64 * half;
    return C_GA + (pn - 28) * 256 + jj;
}
__device__ __forceinline__ void transpose_item(const float* W, int ldw, bf16* WT, int ldd, int koff, int k0, int n0, int src, LAS float* scr, int lane) {
#pragma unroll 8
    for (int i = 0; i < 32; ++i) { const int kk = 2 * i + (lane >> 5); scr[kk * 33 + (lane & 31)] = src >= 0 ? W[(size_t)(k0 + kk) * ldw + src] : 0.f; }
    LDS_WAIT(); asm volatile("" ::: "memory");
    const int c = lane & 7;
#pragma unroll
    for (int j = 0; j < 4; ++j) { const int n = (lane >> 3) + 8 * j; const LAS float* s = scr + (8 * c) * 33 + n;
        v4u o; o.x = cvt_pk_bf16(s[0 * 33], s[1 * 33]); o.y = cvt_pk_bf16(s[2 * 33], s[3 * 33]); o.z = cvt_pk_bf16(s[4 * 33], s[5 * 33]); o.w = cvt_pk_bf16(s[6 * 33], s[7 * 33]);
        *(GAS v4u*)(WT + (size_t)(n0 + n) * ldd + koff + k0 + 8 * c) = o; }
    LDS_WAIT(); asm volatile("" ::: "memory");
}
__device__ __forceinline__ void transpose_item_fp8(const float* W, int ldw, unsigned char* WT8, int ldd, int k0, int n0, int src, LAS float* scr, int lane) {
#pragma unroll 8
    for (int i = 0; i < 32; ++i) { const int kk = 2 * i + (lane >> 5); scr[kk * 33 + (lane & 31)] = W[(size_t)(k0 + kk) * ldw + src] * 64.0f; }
    LDS_WAIT(); asm volatile("" ::: "memory");
    const int c = lane & 7;
#pragma unroll
    for (int j = 0; j < 4; ++j) { const int n = (lane >> 3) + 8 * j; const LAS float* s = scr + (8 * c) * 33 + n;
        int w0 = __builtin_amdgcn_cvt_pk_fp8_f32(s[0 * 33], s[1 * 33], 0, false); w0 = __builtin_amdgcn_cvt_pk_fp8_f32(s[2 * 33], s[3 * 33], w0, true);
        int w1 = __builtin_amdgcn_cvt_pk_fp8_f32(s[4 * 33], s[5 * 33], 0, false); w1 = __builtin_amdgcn_cvt_pk_fp8_f32(s[6 * 33], s[7 * 33], w1, true);
        v2u o; o.x = (unsigned)w0; o.y = (unsigned)w1; *(GAS v2u*)(WT8 + (size_t)(n0 + n) * ldd + k0 + 8 * c) = o; }
    LDS_WAIT(); asm volatile("" ::: "memory");
}
__device__ __forceinline__ void cvt_stream(const float* src, bf16* dst, size_t n8, size_t i0, size_t stride) {
    for (size_t i = i0; i < n8; i += stride) { const f32x4 a = *(const GAS f32x4*)(src + i * 8), b = *(const GAS f32x4*)(src + i * 8 + 4);
        v4u o; o.x = cvt_pk_bf16(a[0], a[1]); o.y = cvt_pk_bf16(a[2], a[3]); o.z = cvt_pk_bf16(b[0], b[1]); o.w = cvt_pk_bf16(b[2], b[3]); *(GAS v4u*)(dst + i * 8) = o; }
}
template <bool OUT_BF16> __device__ __forceinline__ void rmsnorm_row(const float* xrow, const float* g, void* orow, int lane, unsigned char* orow8 = nullptr) {
    const GAS f32x4* xr = (const GAS f32x4*)xrow + lane; const GAS f32x4* gr = (const GAS f32x4*)g + lane;
    f32x4 v[8]; float s = 0.f;
#pragma unroll
    for (int j = 0; j < 8; ++j) { v[j] = xr[64 * j]; s += (v[j].x * v[j].x + v[j].y * v[j].y) + (v[j].z * v[j].z + v[j].w * v[j].w); }
    const float rstd = 1.0f / sqrtf(wave_sum(s) * (1.0f / DM) + EPS);
#pragma unroll
    for (int j = 0; j < 8; ++j) { const f32x4 gg = gr[64 * j]; const f32x4 y = v[j] * rstd * gg;
        if constexpr (OUT_BF16) { v2u o; o.x = cvt_pk_bf16(y.x, y.y); o.y = cvt_pk_bf16(y.z, y.w); ((GAS v2u*)orow)[lane + 64 * j] = o;
            int w8 = __builtin_amdgcn_cvt_pk_fp8_f32(y.x, y.y, 0, false); w8 = __builtin_amdgcn_cvt_pk_fp8_f32(y.z, y.w, w8, true); ((GAS unsigned*)orow8)[lane + 64 * j] = (unsigned)w8; }
        else ((GAS f32x4*)orow)[lane + 64 * j] = y; }
}
__device__ __forceinline__ void p0_prologue(const Frame& F, const Args& A, int l, const float* xp, const float* xs) {
    int tid = F.tid; asm volatile("" : "+v"(tid));
    const int lane = tid & 63, wave = __builtin_amdgcn_readfirstlane(tid >> 6);
    LAS float* scr = (LAS float*)(F.lds + wave * 16384);
    const int gw = F.vcu * NWAVES + wave, NGW = F.G * NWAVES;
    unsigned char* ws = A.ws;
    constexpr int I_A = 32 * (N1A / 32), I_B = 32 * (N8 / 32), I_LA = 16 * 64, I_LB = 8 * 64, I_LC = 8 * 64, I_O = 32 * 64, I_P = 4 * 2 * 4;
    constexpr int NIT = I_A + I_B + I_LA + I_LB + I_LC + I_O + I_P;
#ifndef P0REP
#define P0REP 0
#endif
    for (int rp = 0; rp < ((P0REP & 1) ? 2 : 1); ++rp)
    for (int it = gw; it < NIT; it += NGW) {
        int r = it;
        if (r < I_A) { const int kb = r / (N1A / 32), nb = r % (N1A / 32); transpose_item(A.w_in + (size_t)l * DM * IN_W, IN_W, (bf16*)(ws + WS_W1A), DM, 0, 64 * kb, 32 * nb, colmap_a(32 * nb + (lane & 31)), scr, lane); continue; } r -= I_A;
        if (r < I_B) { const int kb = r / (N8 / 32), nb = r % (N8 / 32); transpose_item_fp8(A.w_in + (size_t)l * DM * IN_W, IN_W, ws + WS_W8, DM, 64 * kb, 32 * nb, colmap_8(32 * nb + (lane & 31)), scr, lane); continue; } r -= I_B;
        if (r < I_LA) { const int kb = r / 64, nb = r % 64; transpose_item(A.lift_a + (size_t)l * 1024 * DM, DM, (bf16*)(ws + WS_WL), DM, 0, 64 * kb, 32 * nb, 32 * nb + (lane & 31), scr, lane); continue; } r -= I_LA;
        if (r < I_LB) { const int kb = r / 64, nb = r % 64; transpose_item(A.lift_b + (size_t)l * 512 * DM, DM, (bf16*)(ws + WS_WL), DM, 1024, 64 * kb, 32 * nb, 32 * nb + (lane & 31), scr, lane); continue; } r -= I_LB;
        if (r < I_LC) { const int kb = r / 64, nb = r % 64; transpose_item(A.lift_c + (size_t)l * 512 * DM, DM, (bf16*)(ws + WS_WL), DM, 1536, 64 * kb, 32 * nb, 32 * nb + (lane & 31), scr, lane); continue; } r -= I_LC;
        if (r < I_O) { const int kb = r / 64, nb = r % 64; transpose_item(A.w_out + (size_t)l * DM * DM, DM, (bf16*)(ws + WS_WO), DM, 0, 64 * kb, 32 * nb, 32 * nb + (lane & 31), scr, lane); continue; } r -= I_O;
        { const int g = r / 8, kb = (r % 8) / 4, nb = r % 4; transpose_item(A.pool_w + (size_t)(l * 4 + g) * 128 * 128, 128, (bf16*)(ws + WS_PW) + g * 128 * 128, 128, 0, 64 * kb, 32 * nb, 32 * nb + (lane & 31), scr, lane); }
    }
    for (int rp = 0; rp < ((P0REP & 2) ? 2 : 1); ++rp)
    {
        const size_t i0 = (size_t)gw * 64 + lane, st = (size_t)NGW * 64;
        cvt_stream(A.cache_k + (size_t)l * NB_S * PAST * 256, (bf16*)(ws + WS_CK), (size_t)NB_S * PAST * 256 / 8, i0, st);
        cvt_stream(A.cache_v + (size_t)l * NB_S * PAST * 256, (bf16*)(ws + WS_CV), (size_t)NB_S * PAST * 256 / 8, i0, st);
        cvt_stream(A.cache_ik + (size_t)l * NB_S * PAST * 64, (bf16*)(ws + WS_CIK), (size_t)NB_S * PAST * 64 / 8, i0, st);
    }
    const float* g = A.norm_g + (size_t)l * DM; bf16* H = (bf16*)(ws + WS_H);
    for (int rp = 0; rp < ((P0REP & 4) ? 2 : 1); ++rp)
    for (int m = gw; m < M; m += NGW) rmsnorm_row<true>(m < MP ? xp + (size_t)m * DM : xs + (size_t)(m - MP) * DM, g, H + (size_t)m * DM, lane, ws + WS_H8 + (size_t)m * DM);
}

typedef pg8::Unit Unit;
#define ACCV(ai, bj, m, i) acc[ai][bj][m][(i) >> 2][(i) & 3]
__device__ __forceinline__ void st_f32x8(float* p, const float (&v)[8]) { *(GAS f32x4*)p = (f32x4){v[0], v[1], v[2], v[3]}; *(GAS f32x4*)(p + 4) = (f32x4){v[4], v[5], v[6], v[7]}; }
__device__ __forceinline__ void st_bf16x8(bf16* p, const float (&v)[8]) { *(GAS v4u*)p = pack8(v); }

template <bool IDX> __device__ __forceinline__ void rope_rows(const f32x4 (&acc)[2][2][4][2], int ai, int m, int row, bool smp, int j0, float sc, float (&o1)[8], float (&o2)[8]) {
    const float pos = (float)(smp ? PAST + (row & 63) : (row & (SEQ - 1)));
#pragma unroll
    for (int i = 0; i < 8; ++i) { const float inv = IDX ? c_inv[2 * ((j0 & 31) + i)] : c_inv[(j0 & 63) + i]; float s, c; sincos_rev(pos * inv, s, c);
        const float x1 = ACCV(ai, 0, m, i) * sc, x2 = ACCV(ai, 1, m, i) * sc; o1[i] = x1 * c - x2 * s; o2[i] = x2 * c + x1 * s; }
}
struct EpiP1 {
    static constexpr bool PERM = true, AFTER_DRAIN = false, FP8 = false; static constexpr int NSEG = 1;
    bf16 *Kb, *Vb, *IKb, *IQb, *Y, *CIN, *PIN; float* IW;
    float *k_p, *k_s, *v_p, *v_s, *ik_p, *ik_s, *cv_p, *cv_s, *pl_p, *pl_s;
    __device__ __forceinline__ void operator()(const f32x4 (&acc)[2][2][4][2], const Unit& u, int wr, int wc, int fr, int fq) const {
        asm volatile("" : "+v"(fr), "+v"(fq));
        const int pn = u.pn; const bool smp = u.pm >= MP / 256;
        const int rbase = u.pm * 256 + wr * 64 + fr, j0 = wc * 32 + fq * 8;
#pragma unroll
        for (int ai = 0; ai < 2; ++ai)
#pragma unroll
            for (int m = 0; m < 4; ++m) {
                const int row = rbase + ai * 128 + m * 16;
                if (pn == 0) {
                    float o1[8], o2[8]; rope_rows<false>(acc, ai, m, row, smp, j0, 1.0f, o1, o2);
                    const int off = (j0 >> 6) * 128 + (j0 & 63); bf16* p = Kb + (size_t)row * 256 + off; st_bf16x8(p, o1); st_bf16x8(p + 64, o2);
                    float* q = (smp ? k_s + (size_t)(row - MP) * 256 : k_p + (size_t)row * 256) + off; st_f32x8(q, o1); st_f32x8(q + 64, o2);
                    continue; }
                if (pn == 2 && wc == 0) {
                    float o1[8], o2[8]; rope_rows<true>(acc, ai, m, row, smp, j0, 1.0f, o1, o2);
                    bf16* p = IKb + (size_t)row * 64 + j0; st_bf16x8(p, o1); st_bf16x8(p + 32, o2);
                    float* q = (smp ? ik_s + (size_t)(row - MP) * 64 : ik_p + (size_t)row * 64) + j0; st_f32x8(q, o1); st_f32x8(q + 32, o2);
                    continue; }
                if (pn >= 3 && pn < 7) {
                    float o1[8], o2[8]; rope_rows<true>(acc, ai, m, row, smp, j0, 1.0f, o1, o2);
                    bf16* p = IQb + (size_t)row * 1024 + (4 * (pn - 3) + (j0 >> 5)) * 64 + (j0 & 31); st_bf16x8(p, o1); st_bf16x8(p + 32, o2);
                    continue; }
                float a[8], b[8];
#pragma unroll
                for (int i = 0; i < 8; ++i) { a[i] = ACCV(ai, 0, m, i); b[i] = ACCV(ai, 1, m, i); }
                if (pn == 1) {
                    bf16* p = Vb + (size_t)row * 256 + j0; st_bf16x8(p, a); st_bf16x8(p + 128, b);
                    float* q = (smp ? v_s + (size_t)(row - MP) * 256 : v_p + (size_t)row * 256) + j0; st_f32x8(q, a); st_f32x8(q + 128, b);
                } else if (pn == 2) {
                    if (wc == 1 && fq < 2) { float* q = IW + (size_t)row * 16 + 8 * fq;
#pragma unroll
                        for (int i = 0; i < 8; ++i) a[i] *= 0.03125f;
                        st_f32x8(q, a); }
                } else if (pn < 11) {
#pragma unroll
                    for (int i = 0; i < 8; ++i) a[i] *= b[i];
                    const int col = (pn - 7) * 128 + j0; st_bf16x8(CIN + (size_t)row * 512 + col, a);
                    const int t = smp ? (row & 63) : (row & (SEQ - 1)), T = smp ? DSEQ : SEQ;
                    if (t >= T - 2) { float* q = smp ? cv_s + ((size_t)((row - MP) >> 6) * 2 + (t - (T - 2))) * 512 + col : cv_p + ((size_t)(row >> 12) * 2 + (t - (T - 2))) * 512 + col; st_f32x8(q, a); }
                } else if (pn < 15) {
#pragma unroll
                    for (int i = 0; i < 8; ++i) a[i] *= siluf_(b[i]);
                    st_bf16x8(Y + (size_t)row * DM + 1024 + (pn - 11) * 128 + j0, a);
                } else {
                    const int col = (pn - 15) * 128 + j0; st_bf16x8(PIN + (size_t)row * 512 + col, a);
                    const int t = smp ? (row & 63) : (row & (SEQ - 1)), T = smp ? DSEQ : SEQ;
                    if (t >= T - 15) { float* q = smp ? pl_s + ((size_t)((row - MP) >> 6) * 15 + (t - (T - 15))) * 512 + col : pl_p + ((size_t)(row >> 12) * 15 + (t - (T - 15))) * 512 + col; st_f32x8(q, a); }
#pragma unroll
                    for (int i = 0; i < 8; ++i) b[i] = siluf_(b[i]);
                    st_bf16x8(Y + (size_t)row * DM + 1536 + col, b);
                }
            }
    }
};
typedef unsigned char u8;
__device__ __forceinline__ unsigned gate_q(float x) { const float q = __builtin_rintf(255.0f * sigmoidf_(x * 0.015625f)); return (unsigned)(q < 1.0f ? 1.0f : q); }
__device__ __forceinline__ void unpack_u8x8(v2u w, float (&v)[8]) {
    v[0] = (float)(w.x & 255u); v[1] = (float)((w.x >> 8) & 255u); v[2] = (float)((w.x >> 16) & 255u); v[3] = (float)(w.x >> 24);
    v[4] = (float)(w.y & 255u); v[5] = (float)((w.y >> 8) & 255u); v[6] = (float)((w.y >> 16) & 255u); v[7] = (float)(w.y >> 24); }
struct EpiP3 {
    static constexpr bool PERM = true, AFTER_DRAIN = false, FP8 = true; static constexpr int NSEG = 1;
    u8* G; bf16 *Qb, *Y;
    __device__ __forceinline__ void operator()(const f32x4 (&acc)[2][2][4][2], const Unit& u, int wr, int wc, int fr, int fq) const {
        asm volatile("" : "+v"(fr), "+v"(fq));
        const int pn = u.pn; const bool smp = u.pm >= MP / 256;
        const int rbase = u.pm * 256 + wr * 64 + fr, j0 = wc * 32 + fq * 8;
#pragma unroll
        for (int ai = 0; ai < 2; ++ai)
#pragma unroll
            for (int m = 0; m < 4; ++m) { const int row = rbase + ai * 128 + m * 16;
                if (pn < 24) { u8* p = G + (size_t)row * N1B + pn * 256 + j0;
#pragma unroll
                    for (int bj = 0; bj < 2; ++bj) { v2u w;
                        w.x = gate_q(ACCV(ai, bj, m, 0)) | (gate_q(ACCV(ai, bj, m, 1)) << 8) | (gate_q(ACCV(ai, bj, m, 2)) << 16) | (gate_q(ACCV(ai, bj, m, 3)) << 24);
                        w.y = gate_q(ACCV(ai, bj, m, 4)) | (gate_q(ACCV(ai, bj, m, 5)) << 8) | (gate_q(ACCV(ai, bj, m, 6)) << 16) | (gate_q(ACCV(ai, bj, m, 7)) << 24);
                        *(GAS v2u*)(p + bj * 128) = w; }
                } else if (pn < 28) {
                    float o1[8], o2[8]; rope_rows<false>(acc, ai, m, row, smp, j0, 0.015625f, o1, o2);
                    bf16* p = Qb + (size_t)row * 1024 + (2 * (pn - 24) + (j0 >> 6)) * 128 + (j0 & 63); st_bf16x8(p, o1); st_bf16x8(p + 64, o2);
                } else {
                    float a[8], b[8];
#pragma unroll
                    for (int i = 0; i < 8; ++i) { a[i] = siluf_(ACCV(ai, 0, m, i) * 0.015625f); b[i] = siluf_(ACCV(ai, 1, m, i) * 0.015625f); }
                    bf16* p = Y + (size_t)row * DM + (pn - 28) * 256 + j0; st_bf16x8(p, a); st_bf16x8(p + 128, b);
                }
            }
    }
};
struct EpiP4 {
    static constexpr bool PERM = true, AFTER_DRAIN = false, FP8 = false; static constexpr int NSEG = 4;
    const u8* G; bf16* Z;
    __device__ __forceinline__ void operator()(f32x4 (&acc)[2][2][4][2], const Unit& u, int wr, int wc, int fr, int fq) const {
        asm volatile("" : "+v"(fr), "+v"(fq));
        if (u.seg == 0) return;
        const int rbase = u.pm * 256 + wr * 64 + fr, c0 = u.pn * 256 + wc * 32 + fq * 8;
        if (u.seg < 3) {
            const int o1 = u.seg == 1 ? 0 : DM;
#pragma unroll
            for (int ai = 0; ai < 2; ++ai)
#pragma unroll
                for (int m = 0; m < 4; ++m) { const u8* p = G + (size_t)(rbase + ai * 128 + m * 16) * N1B + c0 + o1;
#pragma unroll
                    for (int bj = 0; bj < 2; ++bj) { float ga[8], gb[8]; unpack_u8x8(*(const GAS v2u*)(p + bj * 128), ga); unpack_u8x8(*(const GAS v2u*)(p + bj * 128 + DM), gb);
#pragma unroll
                        for (int i = 0; i < 8; ++i) ACCV(ai, bj, m, i) *= ga[i] * __builtin_amdgcn_rcpf(gb[i]); } }
            return;
        }
#pragma unroll
        for (int ai = 0; ai < 2; ++ai) {
            v2u gv[4][2];
#pragma unroll
            for (int m = 0; m < 4; ++m) { const u8* p = G + (size_t)(rbase + ai * 128 + m * 16) * N1B + 2 * DM + c0; gv[m][0] = *(const GAS v2u*)p; gv[m][1] = *(const GAS v2u*)(p + 128); }
            asm volatile("" ::: "memory");
#pragma unroll
            for (int m = 0; m < 4; ++m)
#pragma unroll
                for (int bj = 0; bj < 2; ++bj) { float gc[8], a[8]; unpack_u8x8(gv[m][bj], gc);
#pragma unroll
                    for (int i = 0; i < 8; ++i) a[i] = ACCV(ai, bj, m, i) * (gc[i] * (1.0f / 255.0f));
                    st_bf16x8(Z + (size_t)(rbase + ai * 128 + m * 16) * DM + c0 + bj * 128, a); }
        }
    }
};
struct EpiP5 {
    static constexpr bool PERM = false, AFTER_DRAIN = false, FP8 = false; static constexpr int NSEG = 1;
    const float* xp; const float* xs; float* out;
    __device__ __forceinline__ void operator()(const f32x4 (&acc)[2][2][4][2], const Unit& u, int wr, int wc, int fr, int fq) const {
        asm volatile("" : "+v"(fr), "+v"(fq));
        const int rbase = u.pm * 256 + wr * 64 + fr, c0 = u.pn * 256 + wc * 32 + 4 * fq;
#pragma unroll
        for (int ai = 0; ai < 2; ++ai) {
            f32x4 xv[4][2][2];
#pragma unroll
            for (int m = 0; m < 4; ++m) { const int row = rbase + ai * 128 + m * 16; const float* xr = (row < MP ? xp + (size_t)row * DM : xs + (size_t)(row - MP) * DM) + c0;
#pragma unroll
                for (int bj = 0; bj < 2; ++bj)
#pragma unroll
                    for (int n = 0; n < 2; ++n) xv[m][bj][n] = *(const GAS f32x4*)(xr + bj * 128 + n * 16); }
            asm volatile("" ::: "memory");
#pragma unroll
            for (int m = 0; m < 4; ++m) { float* orow = out + (size_t)(rbase + ai * 128 + m * 16) * DM + c0;
#pragma unroll
                for (int bj = 0; bj < 2; ++bj)
#pragma unroll
                    for (int n = 0; n < 2; ++n) *(GAS f32x4*)(orow + bj * 128 + n * 16) = xv[m][bj][n] + acc[ai][bj][m][n]; }
            asm volatile("" ::: "memory");
        }
    }
};

#ifndef P2PARTS
#define P2PARTS 15
#endif
#ifndef P2REP
#define P2REP 0
#endif
struct P2Ctx {
    const bf16 *Qb, *Kb, *Vb, *IQb, *IKb, *CKb, *CVb, *CIKb, *CIN, *PIN, *PWt; const float* IW; bf16* Y;
    const float *state_conv, *state_pool, *conv_w, *conv_b, *pool_scale;
    unsigned short* S;
    bool rt_true;
};
struct AttnItem { int smp, b, m0, nt, ntp; };
constexpr int SHM_V = 64 * 128 * 2, SHM_K = 64 * 128 * 2, SHM_WS = 2 * SHM_V + 2 * SHM_K;
constexpr int ATT_W = SHM_WS + NWAVES * 256;
constexpr int ATT_QP = ATT_W + 64 * MW * 8;
#ifndef QPARK
#define QPARK 6
#endif
static_assert(ATT_QP + QPARK * 8192 <= LDSCTL_OFF, "attention LDS");
#define KSWZ(row, colB) ((row) * 256 + ((colB) ^ (((row) & 7) << 4)))
#define SBAR() __builtin_amdgcn_sched_barrier(0)
__device__ __forceinline__ int crow(int r, int hi) { return (r & 3) + 8 * (r >> 2) + 4 * hi; }
__device__ __forceinline__ bf16x8 ld8(const bf16* p) { return *reinterpret_cast<const bf16x8*>(p); }
__device__ __forceinline__ int voff(int row, int sc) { return (row >> 5) * 8192 + 2 * ((sc >> 4) * 512 + (row & 31) * 16 + (sc & 8)); }
__device__ __forceinline__ const bf16* kv_tile(const AttnItem& it, const bf16* newb, const bf16* cacheb, int kt, int pitch) {
    if (kt >= it.nt) kt = 0;
    if (it.smp) return kt < PAST / 64 ? cacheb + ((size_t)it.b * PAST + 64 * kt) * pitch : newb + (size_t)it.m0 * pitch;
    return newb + ((size_t)it.b * SEQ + 64 * kt) * pitch;
}
__device__ __forceinline__ unsigned wave_total_u32(unsigned v) {
    v += (unsigned)__builtin_amdgcn_update_dpp(0, (int)v, 0xB1, 0xF, 0xF, true);
    v += (unsigned)__builtin_amdgcn_update_dpp(0, (int)v, 0x4E, 0xF, 0xF, true);
    v += (unsigned)__builtin_amdgcn_update_dpp(0, (int)v, 0x141, 0xF, 0xF, true);
    v += (unsigned)__builtin_amdgcn_update_dpp(0, (int)v, 0x140, 0xF, 0xF, true);
    return (unsigned)__builtin_amdgcn_readlane((int)v, 0) + (unsigned)__builtin_amdgcn_readlane((int)v, 16) + (unsigned)__builtin_amdgcn_readlane((int)v, 32) + (unsigned)__builtin_amdgcn_readlane((int)v, 48);
}

__device__ __forceinline__ void a1_scores(char* shm, const AttnItem& it, const P2Ctx& C, int tid, int wid, int lane) {
    asm volatile("" : "+v"(tid)); lane = tid & 63; wid = __builtin_amdgcn_readfirstlane(tid >> 6);
    const int r32 = lane & 31, hi = lane >> 5;
    bf16x8 a[4][4]; float w[4][16];
#pragma unroll
    for (int p = 0; p < 4; ++p) {
        const int q = 8 * wid + 2 * p + ((r32 >> 2) & 1), head = 4 * (r32 >> 3) + (r32 & 3);
        const bf16* src = C.IQb + (size_t)(it.m0 + q) * 1024 + head * 64 + hi * 8;
#pragma unroll
        for (int ks = 0; ks < 4; ++ks) a[p][ks] = ld8(src + ks * 16);
        const float* wp = C.IW + (size_t)(it.m0 + 8 * wid + 2 * p + hi) * 16;
#pragma unroll
        for (int j = 0; j < 4; ++j) { const f32x4 t = *(const GAS f32x4*)(wp + 4 * j); w[p][4 * j] = t[0]; w[p][4 * j + 1] = t[1]; w[p][4 * j + 2] = t[2]; w[p][4 * j + 3] = t[3]; }
    }
    const int skey = tid >> 3, sch = tid & 7, sdst = skey * 128 + ((sch ^ ((skey >> 1) & 7)) << 4);
#define A1_LD(kt_) (*(const GAS v4u*)(kv_tile(it, C.IKb, C.CIKb, (kt_), 64) + skey * 64 + sch * 8))
    {   const v4u t0 = A1_LD(0); *(v4u*)(shm + sdst) = t0; }
    v4u st0 = {0u, 0u, 0u, 0u}, st1 = st0, st2 = st0, st3 = st0;
    if (1 < it.nt) st0 = A1_LD(1);
    if (2 < it.nt) st1 = A1_LD(2);
    if (3 < it.nt) st2 = A1_LD(3);
    __syncthreads();
    for (int kt = 0; kt < it.nt; ++kt) {
        const bool more = kt + 1 < it.nt;
        if (kt + 4 < it.nt) st3 = A1_LD(kt + 4);
        const char* buf = shm + (kt & 1) * 8192;
        bf16x8 b[4];
#define A1_LDB(ct_) do { const int key_ = 32 * (ct_) + r32; _Pragma("unroll") for (int ks = 0; ks < 4; ++ks) b[ks] = *reinterpret_cast<const bf16x8*>(buf + key_ * 128 + (((2 * ks + hi) ^ ((key_ >> 1) & 7)) << 4)); } while (0)
        A1_LDB(0);
        f32x16 cc[2];
#define A1_MFMA(dst, st) do { dst = f32x16{}; _Pragma("unroll") for (int ks = 0; ks < 4; ++ks) dst = __builtin_amdgcn_mfma_f32_32x32x16_bf16(a[(st) & 3][ks], b[ks], dst, 0, 0, 0); } while (0)
        A1_MFMA(cc[0], 0);
#pragma unroll
        for (int st = 0; st < 8; ++st) {
            if (st == 3) A1_LDB(1);
            if (st + 1 < 8) A1_MFMA(cc[(st + 1) & 1], st + 1);
            __builtin_amdgcn_sched_barrier(0);
            const int p = st & 3, ct = st >> 2; const f32x16& c = cc[st & 1];
            float s0 = 0.f, s1 = 0.f;
#pragma unroll
            for (int r = 0; r < 16; r += 2) { const int c0i = __float_as_int(c[r]), c1i = __float_as_int(c[r + 1]);
                s0 = fmaf(__int_as_float(c0i > 0 ? c0i : 0), w[p][r], s0); s1 = fmaf(__int_as_float(c1i > 0 ? c1i : 0), w[p][r + 1], s1); }
            const float sc = s0 + s1;
            const unsigned hb = (unsigned)__builtin_bit_cast(unsigned short, (_Float16)sc);
            C.S[(size_t)(8 * wid + 2 * p + hi) * SLD + 64 * kt + 32 * ct + r32] = (unsigned short)((hb ^ ((hb & 0x8000u) ? 0xffffu : 0x8000u)) >> 1);
            __builtin_amdgcn_sched_barrier(0);
        }
#undef A1_MFMA
#undef A1_LDB
        if (more) *(v4u*)(shm + ((kt + 1) & 1) * 8192 + sdst) = st0;
        st0 = st1; st1 = st2; st2 = st3;
        __syncthreads();
    }
#undef A1_LD
}
template <int NREG> __device__ __forceinline__ void a2_select(const unsigned short* srow, int nt, LAS unsigned long long* Wq, int lane) {
    unsigned x[NREG];
#pragma unroll
    for (int i = 0; i < NREG; ++i) x[i] = __builtin_nontemporal_load((const unsigned*)srow + 64 * i + lane);
    __builtin_amdgcn_sched_barrier(0);
#pragma unroll
    for (int i = 0; i < NREG; ++i) x[i] = (2 * i + (lane >> 5) < nt) ? (x[i] | 0x80008000u) : 0x80008000u;
    unsigned T = 0u, cntT = 0u;
#pragma unroll 1
    for (int bit = 14; bit >= 0; --bit) {
        const unsigned cand = T | (1u << bit), cc = cand | (cand << 16); unsigned c = 0;
#pragma unroll
        for (int i = 0; i < NREG; ++i) c += (unsigned)__builtin_popcount((x[i] - cc) & 0x80008000u);
        c = wave_total_u32(c);
        if (c >= 256u) { T = cand; cntT = c; if (c == 256u) break; }
    }
    const unsigned cT = T | (T << 16);
    if (cntT == 256u) {
#pragma unroll
        for (int i = 0; i < NREG; ++i) { const unsigned d = x[i] - cT; const unsigned long long b0 = __ballot((d & 0x8000u) != 0u), b1 = __ballot((d & 0x80000000u) != 0u);
            if (lane == 0) { if (2 * i < nt) Wq[2 * i] = (b0 & 0xffffffffull) | (b1 << 32); if (2 * i + 1 < nt) Wq[2 * i + 1] = (b0 >> 32) | (b1 & 0xffffffff00000000ull); } }
    } else {
        unsigned g = 0; const unsigned c1 = cT + 0x00010001u;
#pragma unroll
        for (int i = 0; i < NREG; ++i) g += (unsigned)__builtin_popcount((x[i] - c1) & 0x80008000u);
        g = wave_total_u32(g);
        const unsigned need = 256u - g; unsigned ceq = 0u;
#pragma unroll
        for (int i = 0; i < NREG; ++i) {
            const unsigned klo = x[i] & 0x7fffu, khi = (x[i] >> 16) & 0x7fffu;
            const bool elo = klo == T, ehi = khi == T;
            const unsigned long long qlo = __ballot(elo), qhi = __ballot(ehi);
            const unsigned base = ceq + __builtin_amdgcn_mbcnt_hi((unsigned)(qlo >> 32), __builtin_amdgcn_mbcnt_lo((unsigned)qlo, 0u)) + __builtin_amdgcn_mbcnt_hi((unsigned)(qhi >> 32), __builtin_amdgcn_mbcnt_lo((unsigned)qhi, 0u));
            const unsigned long long b0 = __ballot(klo > T || (elo && base < need)), b1 = __ballot(khi > T || (ehi && base + (elo ? 1u : 0u) < need));
            if (lane == 0) { if (2 * i < nt) Wq[2 * i] = (b0 & 0xffffffffull) | (b1 << 32); if (2 * i + 1 < nt) Wq[2 * i + 1] = (b0 >> 32) | (b1 & 0xffffffff00000000ull); }
            ceq += (unsigned)__popcll(qlo) + (unsigned)__popcll(qhi);
        }
    }
}
__device__ __forceinline__ void partialSM(f32x16& p0, f32x16& p1, float& m_reg, float& msub, float& alpha, unsigned long long wq, int hi) {
    constexpr float SL2E = 0.088388347648318447f * 1.4426950408889634f, THR2 = 8.0f * 1.4426950408889634f;
    const float ninf = -__builtin_inff(); const unsigned we = (unsigned)wq >> (2 * hi), wo = (unsigned)(wq >> 32) >> (2 * hi);
#pragma unroll
    for (int r = 0; r < 16; ++r) { const int c = ((r >> 1) & 1) + 4 * (r >> 2); const unsigned w = (r & 1) ? wo : we; p0[r] = ((w >> c) & 1u) ? p0[r] : ninf; p1[r] = ((w >> (c + 16)) & 1u) ? p1[r] : ninf; }
    float pmax = p0[0];
#pragma unroll
    for (int r = 1; r < 16; ++r) pmax = fmaxf(pmax, p0[r]);
#pragma unroll
    for (int r = 0; r < 16; ++r) pmax = fmaxf(pmax, p1[r]);
    { auto rr = __builtin_amdgcn_permlane32_swap(__float_as_uint(pmax), __float_as_uint(pmax), false, false); pmax = fmaxf(__uint_as_float(rr[0]), __uint_as_float(rr[1])); }
    pmax *= SL2E;
    if (__builtin_expect(__all(pmax - m_reg <= THR2), 1)) { alpha = 1.f; }
    else { float mn = fmaxf(m_reg, pmax); msub = (mn == -__builtin_inff()) ? 0.f : mn; alpha = __builtin_amdgcn_exp2f(m_reg - msub); m_reg = mn; }
    const float nm = -msub;
#pragma unroll
    for (int r = 0; r < 16; ++r) p0[r] = fmaf(p0[r], SL2E, nm);
#pragma unroll
    for (int r = 0; r < 16; ++r) p1[r] = fmaf(p1[r], SL2E, nm);
#pragma unroll
    for (int r = 0; r < 16; ++r) p0[r] = __builtin_amdgcn_exp2f(p0[r]);
}
__device__ __forceinline__ void finishSM(f32x16& p0, f32x16& p1, float alpha, float& l_reg, bf16x8& pa0, bf16x8& pa1, bf16x8& pa2, bf16x8& pa3) {
#pragma unroll
    for (int r = 0; r < 16; ++r) p1[r] = __builtin_amdgcn_exp2f(p1[r]);
    float ps = 0;
#pragma unroll
    for (int r = 0; r < 16; ++r) ps += p0[r];
#pragma unroll
    for (int r = 0; r < 16; ++r) ps += p1[r];
    { auto rr = __builtin_amdgcn_permlane32_swap(__float_as_uint(ps), __float_as_uint(ps), false, false); ps = __uint_as_float(rr[0]) + __uint_as_float(rr[1]); }
    l_reg = l_reg * alpha + ps;
#define PK4(P, BASE, OUT) do { unsigned a0 = cvt_pk_bf16(P[BASE + 0], P[BASE + 1]), a1 = cvt_pk_bf16(P[BASE + 2], P[BASE + 3]); \
    unsigned b0 = cvt_pk_bf16(P[BASE + 4], P[BASE + 5]), b1 = cvt_pk_bf16(P[BASE + 6], P[BASE + 7]); \
    auto r0 = __builtin_amdgcn_permlane32_swap(a0, b0, false, false); auto r1 = __builtin_amdgcn_permlane32_swap(a1, b1, false, false); \
    v4u w = {r0[0], r1[0], r0[1], r1[1]}; OUT = *reinterpret_cast<bf16x8*>(&w); } while (0)
    PK4(p0, 0, pa0); PK4(p0, 8, pa1); PK4(p1, 0, pa2); PK4(p1, 8, pa3);
#undef PK4
}
__device__ __forceinline__ void qkt(f32x16& p0, f32x16& p1, const char* Ks, const bf16x8* qr, const char* qp, int r32, int hi) {
    p0 = f32x16{}; p1 = f32x16{};
#pragma unroll
    for (int d0 = 0; d0 < 8; ++d0) { const int cb = (d0 * 16 + hi * 8) * 2;
        const bf16x8 b0 = *reinterpret_cast<const bf16x8*>(Ks + KSWZ(r32, cb));
        const bf16x8 b1 = *reinterpret_cast<const bf16x8*>(Ks + KSWZ(32 + r32, cb));
        const bf16x8 q = d0 < 8 - QPARK ? qr[d0] : *reinterpret_cast<const bf16x8*>(qp + (d0 - (8 - QPARK)) * 8192);
        p0 = __builtin_amdgcn_mfma_f32_32x32x16_bf16(b0, q, p0, 0, 0, 0);
        p1 = __builtin_amdgcn_mfma_f32_32x32x16_bf16(b1, q, p1, 0, 0, 0); }
}
template <int OFF> __device__ __forceinline__ s16x4 trrd(int vb) { s16x4 r; asm volatile("ds_read_b64_tr_b16 %0,%1 offset:%2" : "=&v"(r) : "v"(vb), "n"(OFF) : "memory"); return r; }
template <int BUF, int D0> __device__ __forceinline__ void pv_one(f32x16& o, int vb, bf16x8 pa0, bf16x8 pa1, bf16x8 pa2, bf16x8 pa3) {
    constexpr int B0 = BUF * SHM_V + D0 * 2048;
    const s16x4 lo0 = trrd<B0>(vb), hi0 = trrd<B0 + 128>(vb), lo1 = trrd<B0 + 512>(vb), hi1 = trrd<B0 + 512 + 128>(vb);
    const s16x4 lo2 = trrd<B0 + 8192>(vb), hi2 = trrd<B0 + 8192 + 128>(vb), lo3 = trrd<B0 + 8192 + 512>(vb), hi3 = trrd<B0 + 8192 + 512 + 128>(vb);
    asm volatile("s_waitcnt lgkmcnt(0)" ::: "memory"); SBAR();
#define PK(l, h) (bf16x8){l[0], l[1], l[2], l[3], h[0], h[1], h[2], h[3]}
    o = __builtin_amdgcn_mfma_f32_32x32x16_bf16(pa0, PK(lo0, hi0), o, 0, 0, 0);
    o = __builtin_amdgcn_mfma_f32_32x32x16_bf16(pa1, PK(lo1, hi1), o, 0, 0, 0);
    o = __builtin_amdgcn_mfma_f32_32x32x16_bf16(pa2, PK(lo2, hi2), o, 0, 0, 0);
    o = __builtin_amdgcn_mfma_f32_32x32x16_bf16(pa3, PK(lo3, hi3), o, 0, 0, 0);
#undef PK
}
template <int BUF> __device__ __forceinline__ void pv_d0(f32x16* o, int vb, bf16x8 pa0, bf16x8 pa1, bf16x8 pa2, bf16x8 pa3) {
    pv_one<BUF, 0>(o[0], vb, pa0, pa1, pa2, pa3); pv_one<BUF, 1>(o[1], vb, pa0, pa1, pa2, pa3); pv_one<BUF, 2>(o[2], vb, pa0, pa1, pa2, pa3); pv_one<BUF, 3>(o[3], vb, pa0, pa1, pa2, pa3);
}
__device__ __forceinline__ void attn_head(char* shm, const AttnItem& it, const P2Ctx& C, int kvh, int tid, int wid, int lane, bool store) {
    asm volatile("" : "+v"(tid)); lane = tid & 63; wid = __builtin_amdgcn_readfirstlane(tid >> 6);
    const int r32 = lane & 31, hi = lane >> 5;
    char* V_lds = shm; char* K_lds = shm + 2 * SHM_V;
    float* wsx = (float*)(shm + SHM_WS) + wid * 64; float* li_l = wsx; float* al_l = wsx + 32;
    const unsigned long long* Wl = (const unsigned long long*)(shm + ATT_W);
    const int pos = 32 * (wid & 1) + r32, head = kvh * 4 + (wid >> 1);
    const unsigned long long* Wrow = Wl + pos * MW;
    const bf16* qrow = C.Qb + (size_t)(it.m0 + pos) * 1024 + head * 128;
    bf16x8 qr[8]; char* qp = shm + ATT_QP + tid * 16;
    float m_reg = -__builtin_inff(), msub = 0.f, l_reg = 0.f; f32x16 o[4] = {};
    const int sr = tid >> 4, sc = (tid & 15) * 8;
    const int vb0 = (int)(uintptr_t)V_lds + (lane & 15) * 8 + ((lane >> 4) & 1) * 1024 + (lane >> 5) * 256;
    bf16x8 sv0, sv1, sk0, sk1;
    const int TPS = it.ntp;
#define SLOAD(kt) do { const bf16* Kt_ = kv_tile(it, C.Kb, C.CKb, (kt), 256) + kvh * 128 + sc; const bf16* Vt_ = kv_tile(it, C.Vb, C.CVb, (kt), 256) + kvh * 128 + sc; \
    sv0 = ld8(Vt_ + (size_t)sr * 256); sv1 = ld8(Vt_ + (size_t)(32 + sr) * 256); sk0 = ld8(Kt_ + (size_t)sr * 256); sk1 = ld8(Kt_ + (size_t)(32 + sr) * 256); } while (0)
#define SWRITE(buf) do { *(bf16x8*)(V_lds + (buf) * SHM_V + voff(sr, sc)) = sv0; *(bf16x8*)(V_lds + (buf) * SHM_V + voff(32 + sr, sc)) = sv1; const int kc = sc * 2; \
    *(bf16x8*)(K_lds + (buf) * SHM_K + KSWZ(sr, kc)) = sk0; *(bf16x8*)(K_lds + (buf) * SHM_K + KSWZ(32 + sr, kc)) = sk1; } while (0)
#define RESC(a) do { if (__any((a) < 1.f)) { if (hi == 0) al_l[r32] = (a); asm volatile("s_waitcnt lgkmcnt(0)" ::: "memory"); \
    _Pragma("unroll") for (int d = 0; d < 4; ++d) _Pragma("unroll") for (int r = 0; r < 16; ++r) o[d][r] *= al_l[crow(r, hi)]; } } while (0)
    f32x16 pA0, pA1, pB0, pB1; float alA, alB; bf16x8 pa0, pa1, pa2, pa3;
#pragma unroll
    for (int d0 = 0; d0 < 8; ++d0) qr[d0] = ld8(qrow + d0 * 16 + hi * 8);
#pragma unroll
    for (int j = 0; j < QPARK; ++j) *reinterpret_cast<bf16x8*>(qp + j * 8192) = qr[8 - QPARK + j];
    SLOAD(0); SWRITE(0); __syncthreads();
    qkt(pA0, pA1, K_lds, qr, qp, r32, hi); partialSM(pA0, pA1, m_reg, msub, alA, Wrow[0], hi);
    SLOAD(1); SWRITE(1); __syncthreads();
    for (int j = 1; j + 1 < TPS; j += 2) {
        SBAR(); qkt(pB0, pB1, K_lds + SHM_K, qr, qp, r32, hi);
        finishSM(pA0, pA1, alA, l_reg, pa0, pa1, pa2, pa3); SBAR();
        SLOAD(j + 1); SBAR();
        pv_d0<0>(o, vb0, pa0, pa1, pa2, pa3); partialSM(pB0, pB1, m_reg, msub, alB, Wrow[j], hi);
        __syncthreads(); asm volatile("s_waitcnt vmcnt(0)" ::: "memory"); SWRITE(0);
        RESC(alB); __syncthreads();
        SBAR(); qkt(pA0, pA1, K_lds, qr, qp, r32, hi);
        finishSM(pB0, pB1, alB, l_reg, pa0, pa1, pa2, pa3); SBAR();
        if (j + 2 < TPS) { SLOAD(j + 2); SBAR(); }
        pv_d0<1>(o, vb0, pa0, pa1, pa2, pa3); partialSM(pA0, pA1, m_reg, msub, alA, Wrow[j + 1], hi);
        __syncthreads(); if (j + 2 < TPS) { asm volatile("s_waitcnt vmcnt(0)" ::: "memory"); SWRITE(1); }
        RESC(alA); __syncthreads();
    }
    SBAR(); qkt(pB0, pB1, K_lds + SHM_K, qr, qp, r32, hi);
    finishSM(pA0, pA1, alA, l_reg, pa0, pa1, pa2, pa3); SBAR();
    pv_d0<0>(o, vb0, pa0, pa1, pa2, pa3); partialSM(pB0, pB1, m_reg, msub, alB, Wrow[TPS - 1], hi);
    __syncthreads(); RESC(alB);
    finishSM(pB0, pB1, alB, l_reg, pa0, pa1, pa2, pa3); SBAR();
    pv_d0<1>(o, vb0, pa0, pa1, pa2, pa3);
#undef SLOAD
#undef SWRITE
#undef RESC
    if (hi == 0) li_l[r32] = l_reg; asm volatile("s_waitcnt lgkmcnt(0)" ::: "memory");
    {
        bf16* ybase = C.Y + (size_t)(it.m0 + 32 * (wid & 1)) * DM + head * 128 + r32;
        unsigned short gq[16][4];
#pragma unroll
        for (int r = 0; r < 16; ++r)
#pragma unroll
            for (int d0 = 0; d0 < 4; ++d0) gq[r][d0] = ybase[(size_t)crow(r, hi) * DM + d0 * 32];
        asm volatile("" ::: "memory");
#pragma unroll
        for (int r = 0; r < 16; ++r) { const float l = li_l[crow(r, hi)]; const float rl = l > 0.f ? __builtin_amdgcn_rcpf(l) : 0.f;
#pragma unroll
            for (int d0 = 0; d0 < 4; ++d0) { if (store) ybase[(size_t)crow(r, hi) * DM + d0 * 32] = (bf16)(cvt_pk_bf16(o[d0][r] * rl * bf2f(gq[r][d0]), 0.f) & 0xffffu); } }
    }
}
__device__ __forceinline__ void attn_item(char* shm, const AttnItem& it, const P2Ctx& C, int tid, int wid, int lane) {
    LAS unsigned long long* Wl = (LAS unsigned long long*)(shm + ATT_W);
    if (it.nt > 4) {
      for (int rep = 0; rep < ((P2REP & 1) ? 2 : 1); ++rep) {
        if constexpr (P2PARTS & 1) for (int r1 = 0; r1 < ((P2REP & 8) ? 2 : 1); ++r1) a1_scores(shm, it, C, tid, wid, lane);
        if constexpr (P2PARTS & 2) for (int r2 = 0; r2 < ((P2REP & 16) ? 2 : 1); ++r2) for (int qi = 0; qi < 8; ++qi) { asm volatile("" : "+v"(lane)); const int q = wid + 8 * qi; const unsigned short* srow = C.S + (size_t)q * SLD; LAS unsigned long long* Wq = Wl + q * MW;
            if (it.nt <= 16) a2_select<8>(srow, it.nt, Wq, lane); else if (it.nt <= 32) a2_select<16>(srow, it.nt, Wq, lane); else if (it.nt <= 48) a2_select<24>(srow, it.nt, Wq, lane); else a2_select<33>(srow, it.nt, Wq, lane); }
        __syncthreads(); }
    } else { for (int i = tid; i < 64 * it.nt; i += NWAVES * 64) Wl[(i / it.nt) * MW + (i % it.nt)] = ~0ull; }
    if (it.ntp > it.nt && tid < 64) Wl[tid * MW + it.nt] = (unsigned long long)(unsigned)(lane >> 8);
    __syncthreads();
    if constexpr (P2PARTS & 4) for (int rep = 0; rep < ((P2REP & 2) ? 2 : 1); ++rep) { const bool st = rep == ((P2REP & 2) ? 1 : 0) || !C.rt_true;
    attn_head(shm, it, C, 0, tid, wid, lane, st); __syncthreads();
    attn_head(shm, it, C, 1, tid, wid, lane, st); __syncthreads(); }
}

constexpr int CP_P = 64 * 1040;
constexpr int DPITCH = 1040;
__device__ __forceinline__ void ld_row8(const bf16* p, float (&v)[8]) { unpack8(*(const GAS v4u*)p, v); }
__device__ __forceinline__ void ld_row8(const float* p, float (&v)[8]) { const f32x4 a = *(const GAS f32x4*)p, b = *(const GAS f32x4*)(p + 4); v[0] = a[0]; v[1] = a[1]; v[2] = a[2]; v[3] = a[3]; v[4] = b[0]; v[5] = b[1]; v[6] = b[2]; v[7] = b[3]; }
__device__ __forceinline__ void cp_item(char* shm, int tile, const P2Ctx& C, int tid, int wid, int lane, bool store) {
    asm volatile("" : "+v"(tid)); lane = tid & 63; wid = __builtin_amdgcn_readfirstlane(tid >> 6);
    const int m0 = tile * 64; const bool smp = m0 >= MP; const int b = smp ? (m0 - MP) >> 6 : m0 >> 12, t0 = smp ? 0 : (m0 & (SEQ - 1)), mb = m0 - t0;
    const int c0 = (tid & 63) * 8, r0 = (tid >> 6) * 8;
    {
        float w0[8], w1[8], w2[8], bias[8]; ld_row8(C.conv_w + c0, w0); ld_row8(C.conv_w + 512 + c0, w1); ld_row8(C.conv_w + 1024 + c0, w2); ld_row8(C.conv_b + c0, bias);
        float xm2[8], xm1[8], x0[8];
#define LDX(tt_, v_) do { const int tt__ = (tt_); if (tt__ >= 0) ld_row8(C.CIN + (size_t)(mb + tt__) * 512 + c0, v_); \
            else if (smp) ld_row8(C.state_conv + ((size_t)b * 2 + (2 + tt__)) * 512 + c0, v_); \
            else { _Pragma("unroll") for (int i_ = 0; i_ < 8; ++i_) v_[i_] = 0.f; } } while (0)
        LDX(t0 + r0 - 2, xm2); LDX(t0 + r0 - 1, xm1);
#pragma unroll
        for (int r = 0; r < 8; ++r) {
            const int t = t0 + r0 + r; LDX(t, x0);
            bf16* yp = C.Y + (size_t)(mb + t) * DM + 1024 + c0; float g[8], y[8]; ld_row8(yp, g);
#pragma unroll
            for (int i = 0; i < 8; ++i) { y[i] = g[i] * (xm2[i] * w0[i] + xm1[i] * w1[i] + x0[i] * w2[i] + bias[i]); xm2[i] = xm1[i]; xm1[i] = x0[i]; }
            if (store) *(GAS v4u*)yp = pack8(y);
        }
#undef LDX
    }
    {
        char* P = shm + CP_P;
        for (int idx = tid; idx < 79 * 64; idx += NWAVES * 64) {
            const int row = idx >> 6, ch = idx & 63, tt = t0 - 15 + row; v4u v = {0u, 0u, 0u, 0u};
            if (tt >= 0) v = *(const GAS v4u*)(C.PIN + (size_t)(mb + tt) * 512 + ch * 8);
            else if (smp) { float h[8]; ld_row8(C.state_pool + ((size_t)b * 15 + (15 + tt)) * 512 + ch * 8, h); v = pack8(h); }
            *(v4u*)(P + row * DPITCH + ch * 16) = v;
        }
        __syncthreads();
        const int wl = 2 << (c0 >> 7);
        const char* Pc = P + c0 * 2;
        float s[8];
#pragma unroll
        for (int i = 0; i < 8; ++i) s[i] = 0.f;
#pragma unroll 1
        for (int j = 1; j < 16; ++j) if (j < wl) { float v[8]; unpack8(*(const v4u*)(Pc + (15 + r0 - j) * DPITCH), v);
#pragma unroll
            for (int i = 0; i < 8; ++i) s[i] += v[i]; }
#pragma unroll 1
        for (int r = 0; r < 8; ++r) {
            const int t = t0 + r0 + r; float pt[8], po[8];
            unpack8(*(const v4u*)(Pc + (15 + r0 + r) * DPITCH), pt);
#pragma unroll
            for (int i = 0; i < 8; ++i) s[i] += pt[i];
            const int cnt = smp ? wl : (t + 1 < wl ? t + 1 : wl); const float rc = 1.0f / (float)cnt;
            float d[8];
#pragma unroll
            for (int i = 0; i < 8; ++i) d[i] = s[i] * rc - pt[i];
            *(v4u*)(shm + (r0 + r) * DPITCH + c0 * 2) = pack8(d);
            unpack8(*(const v4u*)(Pc + (15 + r0 + r - (wl - 1)) * DPITCH), po);
#pragma unroll
            for (int i = 0; i < 8; ++i) s[i] -= po[i];
        }
    }
    __syncthreads();
    {
        const int g = wid >> 1, rh = wid & 1, fr = lane & 15, fq = lane >> 4;
        f32x4 acc[2][8];
#pragma unroll
        for (int mt = 0; mt < 2; ++mt)
#pragma unroll
            for (int nt = 0; nt < 8; ++nt) acc[mt][nt] = (f32x4){0.f, 0.f, 0.f, 0.f};
        bf16x8 af[2][4];
#pragma unroll
        for (int mt = 0; mt < 2; ++mt)
#pragma unroll
            for (int ks = 0; ks < 4; ++ks) af[mt][ks] = *reinterpret_cast<const bf16x8*>(shm + (32 * rh + 16 * mt + fr) * DPITCH + (g * 128 + 32 * ks + 8 * fq) * 2);
#pragma unroll
        for (int nt = 0; nt < 8; ++nt) {
            const bf16* wp = C.PWt + ((size_t)(g * 128 + 16 * nt + fr)) * 128 + 8 * fq;
#pragma unroll
            for (int ks = 0; ks < 4; ++ks) { const bf16x8 bw = ld8(wp + 32 * ks);
#pragma unroll
                for (int mt = 0; mt < 2; ++mt) acc[mt][nt] = __builtin_amdgcn_mfma_f32_16x16x32_bf16(bw, af[mt][ks], acc[mt][nt], 0, 0, 0); }
        }
#pragma unroll
        for (int mt = 0; mt < 2; ++mt)
#pragma unroll
            for (int nt = 0; nt < 8; ++nt) {
                const int row = m0 + 32 * rh + 16 * mt + fr, col = g * 128 + 16 * nt + 4 * fq;
                const f32x4 sc = *(const GAS f32x4*)(C.pool_scale + col); bf16* yp = C.Y + (size_t)row * DM + 1536 + col;
                const v2u gw = *(const GAS v2u*)yp; const f32x4 a = acc[mt][nt];
                v2u o; o.x = cvt_pk_bf16(a[0] * sc[0] * bflo(gw.x), a[1] * sc[1] * bfhi(gw.x)); o.y = cvt_pk_bf16(a[2] * sc[2] * bflo(gw.y), a[3] * sc[3] * bfhi(gw.y));
                if (store) *(GAS v2u*)yp = o;
            }
    }
    __syncthreads();
}
__device__ __forceinline__ void p2_phase(const Frame& F, char* shm, const P2Ctx& C, unsigned* qhead) {
    int tid = F.tid; asm volatile("" : "+v"(tid));
    const int lane = tid & 63, wave = __builtin_amdgcn_readfirstlane(tid >> 6);
    for (;;) {
        if (tid == 0) F.MISC[0] = __hip_atomic_fetch_add(qhead, 1u, __ATOMIC_RELAXED, __HIP_MEMORY_SCOPE_AGENT);
        __syncthreads();
        const int item = (int)F.MISC[0];
        __syncthreads();
        if (item >= N_ITEMS) break;
        if (item < N_ATT_ITEMS) {
            AttnItem it;
            if (item < 16) { it.smp = 1; it.b = item; it.m0 = MP + 64 * item; it.nt = 65; }
            else { const int idx = item - 16, c = 63 - (idx >> 3); it.smp = 0; it.b = idx & 7; it.m0 = it.b * SEQ + 64 * c; it.nt = c + 1; }
            it.ntp = (it.nt + 1) & ~1;
            attn_item(shm, it, C, tid, wave, lane);
        } else if constexpr (P2PARTS & 8) for (int rep = 0; rep < ((P2REP & 4) ? 2 : 1); ++rep) cp_item(shm, item - N_ATT_ITEMS, C, tid, wave, lane, rep == ((P2REP & 4) ? 1 : 0) || !C.rt_true);
    }
}

#ifndef REP_MASK
#define REP_MASK 0
#endif
#define REPS(k, cond) (((REP_MASK >> (k)) & 1) && (cond) ? 2 : 1)
__global__ void __launch_bounds__(NWAVES * 64, 2) fwd_kernel(Args A) {
    extern __shared__ __attribute__((aligned(16))) unsigned char lds[];
    Frame F;
    F.lds = (LAS unsigned char*)lds; F.MISC = (volatile LAS unsigned*)(F.lds + MISC_OFF);
    F.tid = threadIdx.x; F.lane = F.tid & 63; F.wave = __builtin_amdgcn_readfirstlane(F.tid >> 6);
    F.G = gridDim.x; { const int bx = blockIdx.x; F.vcu = (F.G % 8 == 0) ? (bx % 8) * (F.G / 8) + bx / 8 : bx; }
    unsigned char* ws = A.ws; F.ctl = (unsigned*)(ws + WS_CTL);
    for (int u = F.tid; u < (LDS_BYTES - LDSCTL_OFF) / 4; u += NWAVES * 64) ((LAS unsigned*)(F.lds + LDSCTL_OFF))[u] = 0u;
    __syncthreads();
    XcdBarrier bar = xcd_barrier_post(F.ctl + CW_BAR, F.MISC + 8);
    float* const XR = A.out + O_Y;
    bf16* const H = (bf16*)(ws + WS_H); bf16* const Y = (bf16*)(ws + WS_Y); u8* const G = (u8*)(ws + WS_G); bf16* const Z = H;
#pragma unroll 1
    for (int l = 0; l < 2; ++l) {
        const float* xp = l == 0 ? A.x_prompt : XR; const float* xs = l == 0 ? A.x_sample : XR + (size_t)MP * DM;
        p0_prologue(F, A, l, xp, xs);
        xcd_barrier(bar);
#pragma unroll 1
        for (int rep = 0; rep < REPS(1, true); ++rep) {
            pg8::Gemm g{H, (const bf16*)(ws + WS_W1A), M, N1A, DM, DM, DM}; pg8::StaticOrder S; S.init(M, N1A, F.G, (int)blockIdx.x);
            EpiP1 E; E.Kb = (bf16*)(ws + WS_K); E.Vb = (bf16*)(ws + WS_V); E.IKb = (bf16*)(ws + WS_IK); E.IQb = (bf16*)(ws + WS_IQ); E.Y = Y; E.CIN = (bf16*)(ws + WS_CIN); E.PIN = (bf16*)(ws + WS_PIN); E.IW = (float*)(ws + WS_IW);
            E.k_p = A.out + O_KP + (size_t)l * MP * 256; E.k_s = A.out + O_KS + (size_t)l * MS * 256; E.v_p = A.out + O_VP + (size_t)l * MP * 256; E.v_s = A.out + O_VS + (size_t)l * MS * 256;
            E.ik_p = A.out + O_IKP + (size_t)l * MP * 64; E.ik_s = A.out + O_IKS + (size_t)l * MS * 64; E.cv_p = A.out + O_CP + (size_t)l * 8 * 2 * 512; E.cv_s = A.out + O_CS + (size_t)l * 16 * 2 * 512;
            E.pl_p = A.out + O_PP + (size_t)l * 8 * 15 * 512; E.pl_s = A.out + O_PS + (size_t)l * 16 * 15 * 512;
            pg8::gemm_phase<EpiP1, pg8::StaticOrder, true, true>(F.lds, g, S, E);
        }
#pragma unroll 1
        for (int rep = 0; rep < REPS(3, true); ++rep) {
            const int c = (int)((blockIdx.x + 52u) % (unsigned)F.G);
              pg8::Gemm g{(const bf16*)(ws + WS_H8), (const bf16*)(ws + WS_W8), M, N8, DM / 2, DM / 2, DM / 2}; pg8::StaticOrder S; S.init(M, N8, F.G, F.G == 256 ? c : (int)blockIdx.x);
            EpiP3 E; E.G = G; E.Qb = (bf16*)(ws + WS_Q); E.Y = Y;
            pg8::gemm_phase<EpiP3, pg8::StaticOrder, true, true>(F.lds, g, S, E);
        }
        xcd_barrier(bar);
        {
            P2Ctx C; C.Qb = (const bf16*)(ws + WS_Q); C.Kb = (const bf16*)(ws + WS_K); C.Vb = (const bf16*)(ws + WS_V); C.IQb = (const bf16*)(ws + WS_IQ); C.IKb = (const bf16*)(ws + WS_IK);
            C.CKb = (const bf16*)(ws + WS_CK); C.CVb = (const bf16*)(ws + WS_CV); C.CIKb = (const bf16*)(ws + WS_CIK); C.CIN = (const bf16*)(ws + WS_CIN); C.PIN = (const bf16*)(ws + WS_PIN); C.PWt = (const bf16*)(ws + WS_PW);
            C.IW = (const float*)(ws + WS_IW); C.Y = Y;
            C.state_conv = A.state_conv + (size_t)l * 16 * 2 * 512; C.state_pool = A.state_pool + (size_t)l * 16 * 15 * 512; C.conv_w = A.conv_w + (size_t)l * 3 * 512; C.conv_b = A.conv_b + (size_t)l * 512; C.pool_scale = A.pool_scale + (size_t)l * 512;
            C.S = (unsigned short*)(ws + WS_S + (size_t)blockIdx.x * S_WG_BYTES); C.rt_true = F.ctl[3000] == 0u;
            p2_phase(F, (char*)lds, C, F.ctl + CW_QUEUE + 64 * l);
        }
        xcd_barrier(bar);
#pragma unroll 1
        for (int rep = 0; rep < REPS(4, true); ++rep) {
            pg8::Gemm g{Y, (const bf16*)(ws + WS_WL), M, DM, 512, DM, DM}; pg8::SegOrder<4, 512> S; S.init(M, DM, F.G, (int)blockIdx.x);
            EpiP4 E; E.G = G; E.Z = Z;
            pg8::gemm_phase<EpiP4, pg8::SegOrder<4, 512>, true, true>(F.lds, g, S, E);
            xcd_barrier(bar);
        }
#pragma unroll 1
        for (int rep = 0; rep < REPS(5, l == 0); ++rep) {
            pg8::Gemm g{Z, (const bf16*)(ws + WS_WO), M, DM, DM, DM, DM}; pg8::StaticOrder S; S.init(M, DM, F.G, (int)blockIdx.x);
            EpiP5 E; E.xp = xp; E.xs = xs; E.out = XR;
            pg8::gemm_phase<EpiP5, pg8::StaticOrder, true, true>(F.lds, g, S, E);
            xcd_barrier(bar);
        }
    }
    { int tid = F.tid; asm volatile("" : "+v"(tid)); const int lane = tid & 63, wave = __builtin_amdgcn_readfirstlane(tid >> 6);
      const int gw = F.vcu * NWAVES + wave, NGW = F.G * NWAVES;
      for (int m = gw; m < M; m += NGW) rmsnorm_row<false>(XR + (size_t)m * DM, A.final_g, XR + (size_t)m * DM, lane); }
}

extern "C" void kernel_launch(void* const* d_in, const int* in_sizes, int n_in, void* d_out, int out_size, void* d_ws, size_t ws_size, hipStream_t stream) {
    static int grid = 0;
    if (grid == 0) {
        if (n_in != 18 || in_sizes[0] != MP * DM || ws_size < WS_END) { fprintf(stderr, "kernel_launch: unexpected shapes (n_in %d, in0 %d, out %d, ws %zu; need ws >= %zu); nothing launched\n", n_in, n_in > 0 ? in_sizes[0] : -1, out_size, ws_size, (size_t)WS_END); grid = -1; return; }
        int dev = 0, cus = 0, per_cu = 0;
        if (hipGetDevice(&dev) != hipSuccess || hipDeviceGetAttribute(&cus, hipDeviceAttributeMultiprocessorCount, dev) != hipSuccess) { fprintf(stderr, "kernel_launch: device query failed\n"); grid = -1; return; }
        if (hipFuncSetAttribute((const void*)fwd_kernel, hipFuncAttributeMaxDynamicSharedMemorySize, LDS_BYTES) != hipSuccess) { fprintf(stderr, "kernel_launch: hipFuncSetAttribute failed\n"); grid = -1; return; }
        if (hipOccupancyMaxActiveBlocksPerMultiprocessor(&per_cu, (const void*)fwd_kernel, NWAVES * 64, LDS_BYTES) != hipSuccess || per_cu < 1) { fprintf(stderr, "kernel_launch: occupancy query reports %d workgroups per CU\n", per_cu); }
        (void)hipGetLastError();
        grid = cus > 256 ? 256 : cus;
    }
    if (grid < 0) return;
    if (hipMemsetAsync((char*)d_ws + WS_CTL, 0, CTL_ZERO_BYTES, stream) != hipSuccess) { fprintf(stderr, "kernel_launch: memset failed\n"); return; }
    Args a{};
    a.x_prompt = (const float*)d_in[0]; a.x_sample = (const float*)d_in[1]; a.cache_k = (const float*)d_in[2]; a.cache_v = (const float*)d_in[3]; a.cache_ik = (const float*)d_in[4];
    a.state_conv = (const float*)d_in[5]; a.state_pool = (const float*)d_in[6]; a.norm_g = (const float*)d_in[7]; a.w_in = (const float*)d_in[8]; a.conv_w = (const float*)d_in[9]; a.conv_b = (const float*)d_in[10];
    a.pool_w = (const float*)d_in[11]; a.pool_scale = (const float*)d_in[12]; a.lift_a = (const float*)d_in[13]; a.lift_b = (const float*)d_in[14]; a.lift_c = (const float*)d_in[15]; a.w_out = (const float*)d_in[16]; a.final_g = (const float*)d_in[17];
    a.out = (float*)d_out; a.ws = (unsigned char*)d_ws;
    hipLaunchKernelGGL(fwd_kernel, dim3(grid), dim3(NWAVES * 64), LDS_BYTES, stream, a);
    const hipError_t le = hipPeekAtLastError();
    if (le != hipSuccess) fprintf(stderr, "kernel_launch: launch failed: %s\n", hipGetErrorName(le));
}
```
